# Optimizing an MI355X kernel written in HIP

```python
import math
import jax, jax.numpy as jnp
from jax import lax
import numpy as np

D_MODEL = 1024
BATCH = 16
SEQ = 2048
DEPTH = 1

GRID_W = 64
CTX_LEN = 256
N_DIR = 2
S5_WIDTH = 1024
S5_GROUP = 16
S5_GROUPS = S5_WIDTH // S5_GROUP
S5_STATE = 64
S5_DT_MIN = 1e-3
S5_DT_MAX = 1e-1
RWKV_WIDTH = 1024
RWKV_HEAD = 64
RWKV_HEADS = RWKV_WIDTH // RWKV_HEAD
LORA_W = 64
LORA_A = 64
LORA_G = 128
RWKV_COLS = 3 * RWKV_WIDTH + LORA_W + LORA_A + LORA_G
RWKV_SPLITS = (RWKV_WIDTH, 2 * RWKV_WIDTH, 3 * RWKV_WIDTH, 3 * RWKV_WIDTH + LORA_W, 3 * RWKV_WIDTH + LORA_W + LORA_A)
N_IN = S5_WIDTH + RWKV_COLS + 2 * D_MODEL
D_FF = 2816
RMS_EPS = 1e-6
LNX_EPS = 64e-5

kernel_name = "hybrid_s5_rwkv7_convffn_prefix_dit"


def rmsnorm(x, g):
    xf = x.astype(jnp.float32)
    return xf * lax.rsqrt(jnp.mean(xf * xf, -1, keepdims=True) + RMS_EPS) * g.astype(jnp.float32)


def modulate(h, shift, scale):
    return h * (1.0 + scale) + shift


def grid_shift(x):
    b, l, ch = x.shape
    rows = l // GRID_W
    q = ch // 4
    gp = jnp.pad(x.reshape(b, rows, GRID_W, ch), ((0, 0), (1, 1), (1, 1), (0, 0)))
    left = gp[:, 1:-1, :-2, :q]
    right = gp[:, 1:-1, 2:, q:2 * q]
    up = gp[:, :-2, 1:-1, 2 * q:3 * q]
    down = gp[:, 2:, 1:-1, 3 * q:]
    return jnp.concatenate([left, right, up, down], -1).reshape(b, l, ch)


def seq_shift(x):
    h = x.shape[-1] // 2
    xp = jnp.pad(x, ((0, 0), (1, 1), (0, 0)))
    return jnp.concatenate([xp[:, :-2, :h], xp[:, 2:, h:]], -1)


def dwconv3(x, w, b):
    xp = jnp.pad(x, ((0, 0), (1, 1), (0, 0)))
    return xp[:, :-2] * w[0] + xp[:, 1:-1] * w[1] + xp[:, 2:] * w[2] + b


def s5_discretize(a_re, a_im, log_dt, b_re, b_im):
    a_re = a_re.astype(jnp.float32)
    a_im = a_im.astype(jnp.float32)
    dt = jnp.exp(log_dt.astype(jnp.float32))[:, None]
    mag = jnp.exp(a_re * dt)
    lam_r, lam_i = mag * jnp.cos(a_im * dt), mag * jnp.sin(a_im * dt)
    den = a_re * a_re + a_im * a_im
    coef_r = ((lam_r - 1.0) * a_re + lam_i * a_im) / den
    coef_i = (lam_i * a_re - (lam_r - 1.0) * a_im) / den
    b_re = b_re.astype(jnp.float32)
    b_im = b_im.astype(jnp.float32)
    bb_r = coef_r[..., None] * b_re - coef_i[..., None] * b_im
    bb_i = coef_r[..., None] * b_im + coef_i[..., None] * b_re
    return lam_r, lam_i, bb_r, bb_i


def _cplx_combine(e1, e2):
    ar1, ai1, br1, bi1 = e1
    ar2, ai2, br2, bi2 = e2
    return (ar2 * ar1 - ai2 * ai1, ar2 * ai1 + ai2 * ar1,
            ar2 * br1 - ai2 * bi1 + br2, ar2 * bi1 + ai2 * br1 + bi2)


def s5_scan(lam_r, lam_i, bu_r, bu_i, h0, reverse):
    if h0 is not None:
        first = -1 if reverse else 0
        h0_r, h0_i = h0
        bu_r = bu_r.at[:, first].add(lam_r * h0_r - lam_i * h0_i)
        bu_i = bu_i.at[:, first].add(lam_r * h0_i + lam_i * h0_r)
    length = bu_r.shape[1]
    lr = jnp.broadcast_to(lam_r, (1, length) + lam_r.shape)
    li = jnp.broadcast_to(lam_i, (1, length) + lam_i.shape)
    _, _, h_r, h_i = lax.associative_scan(_cplx_combine, (lr, li, bu_r, bu_i), reverse=reverse, axis=1)
    return h_r, h_i


def s5_branch(u_lat, u_ctx, p, need_ctx):
    def grouped(u):
        return u.reshape(u.shape[:2] + (S5_GROUPS, S5_GROUP))

    ug_lat, ug_ctx = grouped(u_lat), grouped(u_ctx)
    y_lat = u_lat * p['s5_d']
    y_ctx = u_ctx * p['s5_d'] if need_ctx else None
    for d in range(N_DIR):
        rev = d == 1
        last = 0 if rev else -1
        lam_r, lam_i, bb_r, bb_i = s5_discretize(p['s5_a_re'][d], p['s5_a_im'][d], p['s5_log_dt'][d],
                                                 p['s5_b_re'][d], p['s5_b_im'][d])
        c_r = p['s5_c_re'][d].astype(jnp.float32)
        c_i = p['s5_c_im'][d].astype(jnp.float32)

        def drive(ug):
            return jnp.einsum('blgc,gpc->blgp', ug, bb_r), jnp.einsum('blgc,gpc->blgp', ug, bb_i)

        def readout(h_r, h_i):
            y = jnp.einsum('blgp,gcp->blgc', h_r, c_r) - jnp.einsum('blgp,gcp->blgc', h_i, c_i)
            return y.reshape(h_r.shape[:2] + (S5_WIDTH,))

        hc_r, hc_i = s5_scan(lam_r, lam_i, *drive(ug_ctx), None, rev)
        hl_r, hl_i = s5_scan(lam_r, lam_i, *drive(ug_lat),
                             (hc_r[:, last], hc_i[:, last]), rev)
        y_lat = y_lat + readout(hl_r, hl_i)
        if need_ctx:
            y_ctx = y_ctx + readout(hc_r, hc_i)

    def glu(y):
        za, zb = jnp.split(jax.nn.gelu(y) @ p['s5_glu_w'], 2, -1)
        return za * jax.nn.sigmoid(zb)

    return glu(y_lat), (glu(y_ctx) if need_ctx else None)


def _heads(t):
    return t.reshape(t.shape[:-1] + (RWKV_HEADS, RWKV_HEAD))


def wkv7_scan(r, decay, k, v, a, b, s0, reverse):
    def step(s, inp):
        rt, wt, kt, vt, at, bt = inp
        sa = jnp.einsum('bhvk,bhk->bhv', s, at)
        s = s * wt[:, :, None, :] + sa[..., None] * bt[:, :, None, :] + vt[..., None] * kt[:, :, None, :]
        return s, jnp.einsum('bhvk,bhk->bhv', s, rt)

    xs = tuple(jnp.moveaxis(t, 1, 0) for t in (r, decay, k, v, a, b))
    s_final, ys = lax.scan(step, s0, xs, reverse=reverse)
    return jnp.moveaxis(ys, 0, 1), s_final


def rwkv7_branch(rw_lat, rw_ctx, p, need_ctx):
    def prepare(rw, shift_fn):
        xs = rw + (shift_fn(rw) - rw) * p['rwkv_mu']
        r, k, v, wd, ad, gd = jnp.split(xs, RWKV_SPLITS, -1)
        kk = _heads(k * p['rwkv_k_k'])
        kk = kk * lax.rsqrt(jnp.maximum(jnp.sum(kk * kk, -1, keepdims=True), 1e-24))
        return (r, k, v, kk, wd, ad), gd

    def direction(parts, d):
        r, k, v, kk, wd, ad = parts
        w_log = -jax.nn.softplus(-(p['rwkv_w0'][d] + jnp.tanh(wd) @ p['rwkv_w_up'][d])) - 0.5
        decay = _heads(jnp.exp(-jnp.exp(w_log)))
        a = _heads(jax.nn.sigmoid(p['rwkv_a0'][d] + ad @ p['rwkv_a_up'][d]))
        kd = _heads(k) * (1.0 + (a - 1.0) * _heads(p['rwkv_k_a']))
        rh, vh = _heads(r), _heads(v)
        bonus = jnp.sum(rh * kd * p['rwkv_r_k'][d], -1, keepdims=True) * vh
        return (rh, decay, kd, vh, -kk, kk * a), bonus

    def readout(wkv, bonus, gd):
        mu = jnp.mean(wkv, -1, keepdims=True)
        var = jnp.mean(jnp.square(wkv - mu), -1, keepdims=True)
        yn = ((wkv - mu) * lax.rsqrt(var + LNX_EPS)).reshape(wkv.shape[:2] + (RWKV_WIDTH,))
        yn = yn * p['rwkv_lnx_g'] + p['rwkv_lnx_b']
        g = jax.nn.sigmoid(gd) @ p['rwkv_g_up']
        return ((yn + bonus.reshape(yn.shape)) * g) @ p['rwkv_w_out']

    parts_l, gd_l = prepare(rw_lat, grid_shift)
    parts_c, gd_c = prepare(rw_ctx, seq_shift)
    batch = rw_lat.shape[0]
    s_zero = jnp.zeros((batch, RWKV_HEADS, RWKV_HEAD, RWKV_HEAD), jnp.float32)
    wkv_l = jnp.zeros(rw_lat.shape[:2] + (RWKV_HEADS, RWKV_HEAD), jnp.float32)
    bonus_l = jnp.zeros_like(wkv_l)
    wkv_c = jnp.zeros(rw_ctx.shape[:2] + (RWKV_HEADS, RWKV_HEAD), jnp.float32)
    bonus_c = jnp.zeros_like(wkv_c)
    for d in range(N_DIR):
        rev = d == 1
        ins_c, bon_c = direction(parts_c, d)
        ins_l, bon_l = direction(parts_l, d)
        ys_c, s_ctx = wkv7_scan(*ins_c, s_zero, rev)
        ys_l, _ = wkv7_scan(*ins_l, s_ctx, rev)
        wkv_l = wkv_l + ys_l
        bonus_l = bonus_l + bon_l
        if need_ctx:
            wkv_c = wkv_c + ys_c
            bonus_c = bonus_c + bon_c
    out_l = readout(wkv_l, bonus_l, gd_l)
    out_c = readout(wkv_c, bonus_c, gd_c) if need_ctx else None
    return out_l, out_c


def parallel_mixer(h_lat, h_ctx, p, need_ctx):
    def parts(h):
        return jnp.split(h @ p['w_in'], [S5_WIDTH, S5_WIDTH + RWKV_COLS], -1)

    u_l, rw_l, gate_l = parts(h_lat)
    u_c, rw_c, gate_c = parts(h_ctx)
    a_l, a_c = s5_branch(u_l, u_c, p, need_ctx)
    b_l, b_c = rwkv7_branch(rw_l, rw_c, p, need_ctx)

    def merge(a, b, gates):
        ga, gb = jnp.split(gates, 2, -1)
        return (jax.nn.sigmoid(ga) * a + jax.nn.sigmoid(gb) * b) @ p['w_out']

    return merge(a_l, b_l, gate_l), (merge(a_c, b_c, gate_c) if need_ctx else None)


def conv_ffn(h, p):
    z = dwconv3(h @ p['ffn_w_up'], p['ffn_conv_w'], p['ffn_conv_b'])
    zg, zv = jnp.split(z, 2, -1)
    return (jax.nn.silu(zg) * zv) @ p['ffn_w_down']


def setup_inputs(seed: int = 0) -> dict:
    key = jax.random.key(seed)
    ks = iter(jax.random.split(key, 48))
    f32 = jnp.float32

    def nrm(shape, s):
        return s * jax.random.normal(next(ks), shape, f32)

    def uni(shape, lo, hi):
        return jax.random.uniform(next(ks), shape, f32, lo, hi)

    L, G, P, GS, H, N = DEPTH, S5_GROUPS, S5_STATE, S5_GROUP, RWKV_HEADS, RWKV_HEAD
    return {
        'x': nrm((BATCH, SEQ, D_MODEL), 1.0),
        'c': nrm((BATCH, D_MODEL), 1.0),
        'ctx': nrm((BATCH, CTX_LEN, D_MODEL), 1.0),
        'c_ctx': nrm((D_MODEL,), 1.0),
        'w_mod': nrm((L, D_MODEL, 6 * D_MODEL), 0.5 * D_MODEL ** -0.5),
        'b_mod': nrm((L, 6 * D_MODEL), 0.01),
        'norm1_g': 1.0 + nrm((L, D_MODEL), 0.02),
        'norm2_g': 1.0 + nrm((L, D_MODEL), 0.02),
        'w_in': nrm((L, D_MODEL, N_IN), D_MODEL ** -0.5),
        's5_a_re': -0.5 + nrm((L, N_DIR, G, P), 0.01),
        's5_a_im': math.pi * jnp.arange(P, dtype=f32) + nrm((L, N_DIR, G, P), 0.01),
        's5_log_dt': uni((L, N_DIR, G), math.log(S5_DT_MIN), math.log(S5_DT_MAX)),
        's5_b_re': nrm((L, N_DIR, G, P, GS), (2 * GS) ** -0.5),
        's5_b_im': nrm((L, N_DIR, G, P, GS), (2 * GS) ** -0.5),
        's5_c_re': nrm((L, N_DIR, G, GS, P), 0.5),
        's5_c_im': nrm((L, N_DIR, G, GS, P), 0.5),
        's5_d': nrm((L, S5_WIDTH), 0.5),
        's5_glu_w': nrm((L, S5_WIDTH, 2 * D_MODEL), S5_WIDTH ** -0.5),
        'rwkv_mu': uni((L, RWKV_COLS), 0.0, 1.0),
        'rwkv_w0': uni((L, N_DIR, RWKV_WIDTH), -6.0, -1.0),
        'rwkv_w_up': nrm((L, N_DIR, LORA_W, RWKV_WIDTH), 0.5 * LORA_W ** -0.5),
        'rwkv_a0': nrm((L, N_DIR, RWKV_WIDTH), 0.3),
        'rwkv_a_up': nrm((L, N_DIR, LORA_A, RWKV_WIDTH), 0.5 * LORA_A ** -0.5),
        'rwkv_g_up': nrm((L, LORA_G, RWKV_WIDTH), LORA_G ** -0.5),
        'rwkv_k_k': 0.85 + nrm((L, RWKV_WIDTH), 0.02),
        'rwkv_k_a': 1.0 + nrm((L, RWKV_WIDTH), 0.02),
        'rwkv_r_k': nrm((L, N_DIR, H, N), 0.1),
        'rwkv_lnx_g': 1.0 + nrm((L, RWKV_WIDTH), 0.02),
        'rwkv_lnx_b': nrm((L, RWKV_WIDTH), 0.01),
        'rwkv_w_out': nrm((L, RWKV_WIDTH, D_MODEL), RWKV_WIDTH ** -0.5),
        'w_out': nrm((L, D_MODEL, D_MODEL), D_MODEL ** -0.5),
        'ffn_w_up': nrm((L, D_MODEL, 2 * D_FF), D_MODEL ** -0.5),
        'ffn_conv_w': nrm((L, 3, 2 * D_FF), 3 ** -0.5),
        'ffn_conv_b': nrm((L, 2 * D_FF), 0.01),
        'ffn_w_down': nrm((L, D_FF, D_MODEL), D_FF ** -0.5),
        'final_norm_g': 1.0 + nrm((D_MODEL,), 0.02),
    }


def reference(x, c, ctx, c_ctx, w_mod, b_mod, norm1_g, norm2_g, w_in,
              s5_a_re, s5_a_im, s5_log_dt, s5_b_re, s5_b_im, s5_c_re, s5_c_im, s5_d, s5_glu_w,
              rwkv_mu, rwkv_w0, rwkv_w_up, rwkv_a0, rwkv_a_up, rwkv_g_up, rwkv_k_k, rwkv_k_a, rwkv_r_k,
              rwkv_lnx_g, rwkv_lnx_b, rwkv_w_out, w_out, ffn_w_up, ffn_conv_w, ffn_conv_b, ffn_w_down,
              final_norm_g):
    out_dtype = x.dtype
    h_x = x.astype(jnp.float32)
    h_c = ctx.astype(jnp.float32)
    cond = jax.nn.silu(c.astype(jnp.float32))
    cond_ctx = jax.nn.silu(c_ctx.astype(jnp.float32))
    for layer in range(DEPTH):
        need_ctx = layer < DEPTH - 1
        p = dict(
            w_in=w_in[layer], w_out=w_out[layer],
            s5_a_re=s5_a_re[layer], s5_a_im=s5_a_im[layer], s5_log_dt=s5_log_dt[layer],
            s5_b_re=s5_b_re[layer], s5_b_im=s5_b_im[layer], s5_c_re=s5_c_re[layer], s5_c_im=s5_c_im[layer],
            s5_d=s5_d[layer], s5_glu_w=s5_glu_w[layer],
            rwkv_mu=rwkv_mu[layer], rwkv_w0=rwkv_w0[layer], rwkv_w_up=rwkv_w_up[layer],
            rwkv_a0=rwkv_a0[layer], rwkv_a_up=rwkv_a_up[layer], rwkv_g_up=rwkv_g_up[layer],
            rwkv_k_k=rwkv_k_k[layer], rwkv_k_a=rwkv_k_a[layer], rwkv_r_k=rwkv_r_k[layer],
            rwkv_lnx_g=rwkv_lnx_g[layer], rwkv_lnx_b=rwkv_lnx_b[layer], rwkv_w_out=rwkv_w_out[layer],
            ffn_w_up=ffn_w_up[layer], ffn_conv_w=ffn_conv_w[layer], ffn_conv_b=ffn_conv_b[layer],
            ffn_w_down=ffn_w_down[layer],
        )
        mod = (cond @ w_mod[layer] + b_mod[layer])[:, None, :]
        mod_c = cond_ctx @ w_mod[layer] + b_mod[layer]
        sh1, sc1, gt1, sh2, sc2, gt2 = jnp.split(mod, 6, -1)
        sh1c, sc1c, gt1c, sh2c, sc2c, gt2c = jnp.split(mod_c, 6, -1)

        h_lat = modulate(rmsnorm(h_x, norm1_g[layer]), sh1, sc1)
        h_ctx = modulate(rmsnorm(h_c, norm1_g[layer]), sh1c, sc1c)
        mix_l, mix_c = parallel_mixer(h_lat, h_ctx, p, need_ctx)
        h_x = h_x + gt1 * mix_l
        h_x = h_x + gt2 * conv_ffn(modulate(rmsnorm(h_x, norm2_g[layer]), sh2, sc2), p)
        if need_ctx:
            h_c = h_c + gt1c * mix_c
            h_c = h_c + gt2c * conv_ffn(modulate(rmsnorm(h_c, norm2_g[layer]), sh2c, sc2c), p)
    return rmsnorm(h_x, final_norm_g).astype(out_dtype)
```

```cpp
#include <hip/hip_runtime.h>
#include <hip/hip_cooperative_groups.h>
#include <cstdio>
#include <cstdint>
namespace cg = cooperative_groups;

namespace pg8 {
#define PG8_LAS __attribute__((address_space(3)))
typedef unsigned short bf16_t;
typedef short bf16x8 __attribute__((ext_vector_type(8)));
typedef float f32x4 __attribute__((ext_vector_type(4)));
typedef unsigned u32x4 __attribute__((ext_vector_type(4)));
constexpr int BM = 256, BK = 64, HALF = 128, HTB = HALF * BK * 2, STAGE_BYTES = 8 * HTB, NXCD = 8, WGM = 8;

__host__ __device__ __forceinline__ int lds_byte(int r, int c) { const int st = (r >> 4) * 2 + (c >> 5), rr = r & 15, cc = c & 31, ob = rr * 64 + cc * 2; return st * 1024 + (ob ^ (((ob >> 9) & 1) << 5)); }
__host__ __device__ __forceinline__ void stage_rc(int b, int& R, int& C) { const int st = b / 1024, sb = b % 1024, swz = sb ^ (((sb >> 9) & 1) << 5); R = (st >> 1) * 16 + swz / 64; C = (st & 1) * 32 + (swz % 64) / 2; }
__host__ __device__ __forceinline__ int perm32(int rho) { const int n = rho >> 4, i = rho & 15; return 8 * (i >> 2) + 4 * n + (i & 3); }

struct Unit { int pm, pn; };
struct Gemm { const bf16_t* A; const bf16_t* Bt; int M, N, K; };

struct StaticOrder {
    int nM, nN, nwg, G, c;
    __host__ __device__ void init(int M, int N, int G_, int c_) { nM = M / BM; nN = N / BM; nwg = nM * nN; G = G_; c = c_; }
    __host__ __device__ bool next(int i, Unit& u) const {
        const long L = (long)i * G + c; if (L >= nwg) return false;
        int wgid = (int)L; { const int q = nwg / NXCD, r = nwg % NXCD, xcd = wgid % NXCD, off = wgid / NXCD; wgid = (xcd < r ? xcd * (q + 1) : r * (q + 1) + (xcd - r) * q) + off; }
        const int nig = WGM * nN, gid = wgid / nig, fm = gid * WGM, gsz = (nM - fm) < WGM ? (nM - fm) : WGM;
        u.pm = fm + ((wgid % nig) % gsz); u.pn = (wgid % nig) / gsz; return true;
    }
};

typedef float f32x2_cv __attribute__((ext_vector_type(2)));
typedef __bf16 bf16x2_cv __attribute__((ext_vector_type(2)));
__device__ __forceinline__ unsigned cvt_pk_bf16(float lo, float hi) { const bf16x2_cv v = __builtin_convertvector((f32x2_cv){lo, hi}, bf16x2_cv); return __builtin_bit_cast(unsigned, v); }

template <class Epi>
__device__ __forceinline__ void gemm_phase(PG8_LAS unsigned char* lds, const Gemm g, const StaticOrder& S, const Epi& E) {
    int tid_ = threadIdx.x; asm volatile("" : "+v"(tid_));
    const int tid = tid_, wid = __builtin_amdgcn_readfirstlane(tid >> 6), lane = tid & 63, wr = wid >> 2, wc = wid & 3, fr = lane & 15, fq = lane >> 4;
    const int K = g.K, nt = K / BK;
    unsigned voffA[2], voffB[2];
#pragma unroll
    for (int i = 0; i < 2; ++i) { int R, C; stage_rc(tid * 16 + i * 8192, R, C); const int Rb = Epi::PERM ? ((R & ~31) + perm32(R & 31)) : R;
        voffA[i] = (unsigned)(R * K + C) * 2u; voffB[i] = (unsigned)(Rb * K + C) * 2u; }
    const size_t kstep = (size_t)(BK * 2);
    const size_t hstep = (size_t)HALF * K * 2;
    const size_t tstep = 2 * hstep;
    const unsigned ldsw = (unsigned)wid * 1024u;
    const int aoff = lds_byte(wr * 64 + fr, fq * 8), boff = lds_byte(wc * 32 + fr, fq * 8);
#define PG8_SA(b, h) (((b) * 2 + (h)) * HTB)
#define PG8_SB(b, h) ((4 + (b) * 2 + (h)) * HTB)
#define PG8_STAGE(bufoff, gbase, voff) do { _Pragma("unroll") for (int _i = 0; _i < 2; ++_i) \
        __builtin_amdgcn_global_load_lds((const unsigned*)((const char*)(gbase) + (voff)[_i]), (PG8_LAS unsigned*)(lds + (bufoff) + ldsw + _i * 8192), 16, 0, 0); } while (0)
#define PG8_LDA(dst, b, h) do { _Pragma("unroll") for (int m = 0; m < 4; ++m) _Pragma("unroll") for (int k = 0; k < 2; ++k) dst[m][k] = *(const PG8_LAS bf16x8*)(lds + PG8_SA(b, h) + aoff + m * 2048 + k * 1024); } while (0)
#define PG8_LDB(dst, b, h) do { _Pragma("unroll") for (int n = 0; n < 2; ++n) _Pragma("unroll") for (int k = 0; k < 2; ++k) dst[n][k] = *(const PG8_LAS bf16x8*)(lds + PG8_SB(b, h) + boff + n * 2048 + k * 1024); } while (0)
#define PG8_MMA(ai, bj, At, Bt) do { __builtin_amdgcn_s_setprio(1); _Pragma("unroll") for (int m = 0; m < 4; ++m) _Pragma("unroll") for (int n = 0; n < 2; ++n) _Pragma("unroll") for (int k = 0; k < 2; ++k) \
        acc[ai][bj][m][n] = __builtin_amdgcn_mfma_f32_16x16x32_bf16(Bt[n][k], At[m][k], acc[ai][bj][m][n], 0, 0, 0); __builtin_amdgcn_s_setprio(0); } while (0)
#define PG8_WAIT_V(n) asm volatile("s_waitcnt vmcnt(" #n ")" ::: "memory")
#define PG8_WAIT_L(n) asm volatile("s_waitcnt lgkmcnt(" #n ")" ::: "memory")
#define PG8_BAR __builtin_amdgcn_s_barrier()
#define PG8_SCHED __builtin_amdgcn_sched_barrier(0)
    Unit cur, nxt; int ui = 0;
    if (!S.next(0, cur)) return;
    f32x4 acc[2][2][4][2];
#pragma unroll
    for (int a = 0; a < 2; ++a)
#pragma unroll
        for (int b = 0; b < 2; ++b)
#pragma unroll
            for (int m = 0; m < 4; ++m)
#pragma unroll
                for (int n = 0; n < 2; ++n) acc[a][b][m][n] = (f32x4){0.f, 0.f, 0.f, 0.f};
    bf16x8 At[4][2], B0[2][2], B1[2][2];
    const char* cA = (const char*)g.A + (size_t)cur.pm * tstep; const char* cB = (const char*)g.Bt + (size_t)cur.pn * tstep;
    PG8_STAGE(PG8_SB(0, 0), cB, voffB); PG8_STAGE(PG8_SA(0, 0), cA, voffA); PG8_STAGE(PG8_SB(0, 1), cB + hstep, voffB); PG8_STAGE(PG8_SA(0, 1), cA + hstep, voffA);
    if (wr == 1) PG8_BAR;
    PG8_WAIT_V(4); PG8_BAR;
    PG8_STAGE(PG8_SB(1, 0), cB + kstep, voffB); PG8_STAGE(PG8_SA(1, 0), cA + kstep, voffA); PG8_STAGE(PG8_SB(1, 1), cB + hstep + kstep, voffB);
    PG8_WAIT_V(6); PG8_BAR;
    for (;;) {
        const bool has_next = S.next(ui + 1, nxt);
        const char* nA = has_next ? (const char*)g.A + (size_t)nxt.pm * tstep : cA; const char* nB = has_next ? (const char*)g.Bt + (size_t)nxt.pn * tstep : cB;
        for (int t = 0; t < nt; t += 2) {
            const bool last = (t == nt - 2);
            const char* a1 = cA + (size_t)(t + 1) * kstep;
            const char* a2 = last ? nA : cA + (size_t)(t + 2) * kstep; const char* b2 = last ? nB : cB + (size_t)(t + 2) * kstep;
            const char* a3 = a2 + kstep; const char* b3 = b2 + kstep;
            PG8_LDB(B0, 0, 0); PG8_SCHED; PG8_LDA(At, 0, 0); PG8_STAGE(PG8_SA(1, 1), a1 + hstep, voffA);
            PG8_WAIT_L(8); PG8_BAR; PG8_WAIT_L(0); PG8_MMA(0, 0, At, B0); PG8_BAR; PG8_SCHED;
            PG8_LDB(B1, 0, 1); PG8_STAGE(PG8_SB(0, 0), b2, voffB);
            PG8_BAR; PG8_WAIT_L(0); PG8_MMA(0, 1, At, B1); PG8_BAR;
            PG8_LDA(At, 0, 1); PG8_STAGE(PG8_SA(0, 0), a2, voffA);
            PG8_BAR; PG8_WAIT_L(0); PG8_MMA(1, 0, At, B0); PG8_BAR; PG8_SCHED;
            PG8_STAGE(PG8_SB(0, 1), b2 + hstep, voffB);
            PG8_WAIT_V(6); PG8_BAR; PG8_MMA(1, 1, At, B1); PG8_BAR;
            PG8_LDB(B0, 1, 0); PG8_SCHED; PG8_LDA(At, 1, 0); PG8_STAGE(PG8_SA(0, 1), a2 + hstep, voffA);
            PG8_WAIT_L(8); PG8_BAR; PG8_WAIT_L(0); PG8_MMA(0, 0, At, B0); PG8_BAR; PG8_SCHED;
            PG8_LDB(B1, 1, 1); PG8_STAGE(PG8_SB(1, 0), b3, voffB);
            PG8_BAR; PG8_WAIT_L(0); PG8_MMA(0, 1, At, B1); PG8_BAR;
            PG8_LDA(At, 1, 1); PG8_STAGE(PG8_SA(1, 0), a3, voffA);
            PG8_BAR; PG8_WAIT_L(0); PG8_MMA(1, 0, At, B0); PG8_BAR; PG8_SCHED;
            PG8_STAGE(PG8_SB(1, 1), b3 + hstep, voffB);
            PG8_WAIT_V(6); PG8_BAR; PG8_MMA(1, 1, At, B1); PG8_BAR;
        }
        E(acc, cur, wr, wc, fr, fq);
        if (!has_next) break;
#pragma unroll
        for (int a = 0; a < 2; ++a)
#pragma unroll
            for (int b = 0; b < 2; ++b)
#pragma unroll
                for (int m = 0; m < 4; ++m)
#pragma unroll
                    for (int n = 0; n < 2; ++n) acc[a][b][m][n] = (f32x4){0.f, 0.f, 0.f, 0.f};
        cur = nxt; cA = nA; cB = nB; ++ui;
    }
    PG8_WAIT_V(0);
    if (wr == 0) PG8_BAR;
    PG8_BAR;
#undef PG8_SA
#undef PG8_SB
#undef PG8_STAGE
#undef PG8_LDA
#undef PG8_LDB
#undef PG8_MMA
#undef PG8_WAIT_V
#undef PG8_WAIT_L
#undef PG8_BAR
#undef PG8_SCHED
}
}
#define LAS __attribute__((address_space(3)))
typedef unsigned short bf16_t;
typedef short bf16x8 __attribute__((ext_vector_type(8)));
typedef float f32x4 __attribute__((ext_vector_type(4)));
typedef float f32x2 __attribute__((ext_vector_type(2)));
typedef unsigned u32x4 __attribute__((ext_vector_type(4)));
typedef unsigned u32x2 __attribute__((ext_vector_type(2)));

constexpr int NB = 16, SEQ = 2048, DM = 1024, CTXL = 256;
constexpr int T = NB * SEQ, TC = NB * CTXL, TA = T + TC;
constexpr int RWC = 3328, DFF = 2816, NMOD = 6144;
constexpr int NWAVES = 8;
constexpr int LDS_BYTES = 155648;

constexpr size_t MiB = 1u << 20;
constexpr size_t WS_WIN_A = 0, WS_WIN_G = 9 * MiB, WS_WGLU = 13 * MiB, WS_WROUT = 17 * MiB, WS_WOUT = 19 * MiB, WS_WUP = 21 * MiB, WS_WDOWN = 32 * MiB;
constexpr size_t WS_WUPT = 38 * MiB, WS_AUPT = WS_WUPT + 256 * 1024, WS_GUPT = WS_AUPT + 256 * 1024;
constexpr size_t WS_MOD = 39 * MiB, WS_LAM = 40 * MiB, WS_BBT = 40 * MiB + 512 * 1024, WS_CT = 41 * MiB + 512 * 1024, WS_BETA = 43 * MiB;
constexpr size_t WS_BAR = 47 * MiB;
constexpr size_t WS_HB = 48 * MiB, WS_U = 120 * MiB, WS_RW = 192 * MiB, WS_YG = 426 * MiB;
constexpr size_t WS_GA = 192 * MiB, WS_GB = 256 * MiB, WS_RPRE = 120 * MiB, WS_MERGED = 120 * MiB;
constexpr size_t WS_ZPRE = 112 * MiB, WS_ACT = 288 * MiB, WS_END = 512 * MiB;

struct Args { const float* in[36]; float* out; unsigned char* ws; };

__device__ __forceinline__ float bf_lo(unsigned w) { return __uint_as_float(w << 16); }
__device__ __forceinline__ float bf_hi(unsigned w) { return __uint_as_float(w & 0xffff0000u); }
__device__ __forceinline__ float bf2f(bf16_t h) { return __uint_as_float(((unsigned)h) << 16); }
__device__ __forceinline__ unsigned pk2(float a, float b) { return pg8::cvt_pk_bf16(a, b); }
__device__ __forceinline__ bf16_t f2bf(float f) { return (bf16_t)(pk2(f, 0.f) & 0xffffu); }
__device__ __forceinline__ float sigm(float x) { return __builtin_amdgcn_rcpf(1.f + __expf(-x)); }
__device__ __forceinline__ float tanh_(float x) { return 1.f - 2.f * __builtin_amdgcn_rcpf(__expf(2.f * x) + 1.f); }
__device__ __forceinline__ float gelu_tanh(float x) { const float z = 1.5957691216057308f * (x + 0.044715f * x * x * x); return x * sigm(z); }
__device__ __forceinline__ float wave_sum(float v) {
#pragma unroll
    for (int o = 1; o < 64; o <<= 1) v += __shfl_xor(v, o);
    return v;
}
__device__ __forceinline__ void unpack8(const u32x4 w, float* o) { o[0] = bf_lo(w.x); o[1] = bf_hi(w.x); o[2] = bf_lo(w.y); o[3] = bf_hi(w.y); o[4] = bf_lo(w.z); o[5] = bf_hi(w.z); o[6] = bf_lo(w.w); o[7] = bf_hi(w.w); }
__device__ __forceinline__ u32x4 pack8(const float* v) { u32x4 o; o.x = pk2(v[0], v[1]); o.y = pk2(v[2], v[3]); o.z = pk2(v[4], v[5]); o.w = pk2(v[6], v[7]); return o; }
__device__ __forceinline__ bf16x8 as_bf16x8(u32x4 v) { return __builtin_bit_cast(bf16x8, v); }
#define LDS_WAIT() asm volatile("s_waitcnt lgkmcnt(0)" ::: "memory")
#define WAVE_SYNC() do { asm volatile("s_waitcnt lgkmcnt(0)" ::: "memory"); __builtin_amdgcn_wave_barrier(); } while (0)
template <int CTRL> __device__ __forceinline__ float dpp_f(float v) { return __builtin_bit_cast(float, __builtin_amdgcn_update_dpp(0, __builtin_bit_cast(int, v), CTRL, 0xF, 0xF, true)); }
__device__ __forceinline__ float red8(float v) { v += dpp_f<0xB1>(v); v += dpp_f<0x4E>(v); v += dpp_f<0x141>(v); return v; }

using pg8::Unit;
struct EpiSplitUR {
    static constexpr bool PERM = true;
    bf16_t* U; bf16_t* RW;
    __device__ __forceinline__ void operator()(const f32x4 (&acc)[2][2][4][2], const Unit& u, int wr, int wc, int fr, int fq) const {
        int colt = u.pn * 256; bf16_t* base; int ldc;
        if (colt < 1024) { base = U; ldc = 1024; } else { base = RW; ldc = RWC; colt -= 1024; }
        const int row0 = u.pm * 256 + wr * 64 + fr, col0 = colt + wc * 32 + 8 * fq;
#pragma unroll
        for (int ai = 0; ai < 2; ++ai)
#pragma unroll
            for (int m = 0; m < 4; ++m) { bf16_t* rowp = base + (size_t)(row0 + ai * 128 + m * 16) * ldc + col0;
#pragma unroll
                for (int bj = 0; bj < 2; ++bj) { const f32x4 v0 = acc[ai][bj][m][0], v1 = acc[ai][bj][m][1];
                    u32x4 w; w.x = pk2(v0[0], v0[1]); w.y = pk2(v0[2], v0[3]); w.z = pk2(v1[0], v1[1]); w.w = pk2(v1[2], v1[3]);
                    *(u32x4*)(rowp + bj * 128) = w; } }
    }
};
struct EpiPlainBf16 {
    static constexpr bool PERM = true;
    bf16_t* O; int ldc;
    __device__ __forceinline__ void operator()(const f32x4 (&acc)[2][2][4][2], const Unit& u, int wr, int wc, int fr, int fq) const {
        const int row0 = u.pm * 256 + wr * 64 + fr, col0 = u.pn * 256 + wc * 32 + 8 * fq;
#pragma unroll
        for (int ai = 0; ai < 2; ++ai)
#pragma unroll
            for (int m = 0; m < 4; ++m) { bf16_t* rowp = O + (size_t)(row0 + ai * 128 + m * 16) * ldc + col0;
#pragma unroll
                for (int bj = 0; bj < 2; ++bj) { const f32x4 v0 = acc[ai][bj][m][0], v1 = acc[ai][bj][m][1];
                    u32x4 w; w.x = pk2(v0[0], v0[1]); w.y = pk2(v0[2], v0[3]); w.z = pk2(v1[0], v1[1]); w.w = pk2(v1[2], v1[3]);
                    *(u32x4*)(rowp + bj * 128) = w; } }
    }
};
struct EpiGlu {
    static constexpr bool PERM = true;
    bf16_t* O;
    __device__ __forceinline__ void operator()(const f32x4 (&acc)[2][2][4][2], const Unit& u, int wr, int wc, int fr, int fq) const {
        const int row0 = u.pm * 256 + wr * 64 + fr, col0 = u.pn * 128 + wc * 32 + 8 * fq;
#pragma unroll
        for (int ai = 0; ai < 2; ++ai)
#pragma unroll
            for (int m = 0; m < 4; ++m) { bf16_t* rowp = O + (size_t)(row0 + ai * 128 + m * 16) * DM + col0;
                float o[8];
#pragma unroll
                for (int n = 0; n < 2; ++n)
#pragma unroll
                    for (int e = 0; e < 4; ++e) o[4 * n + e] = acc[ai][0][m][n][e] * sigm(acc[ai][1][m][n][e]);
                *(u32x4*)rowp = pack8(o); }
    }
};
struct EpiMerge {
    static constexpr bool PERM = true;
    const bf16_t* A; const bf16_t* B; bf16_t* O;
    __device__ __forceinline__ void operator()(const f32x4 (&acc)[2][2][4][2], const Unit& u, int wr, int wc, int fr, int fq) const {
        const int row0 = u.pm * 256 + wr * 64 + fr, col0 = u.pn * 128 + wc * 32 + 8 * fq;
#pragma unroll
        for (int ai = 0; ai < 2; ++ai)
#pragma unroll
            for (int m = 0; m < 4; ++m) { const size_t off = (size_t)(row0 + ai * 128 + m * 16) * DM + col0;
                float av[8], bv[8], o[8];
                unpack8(*(const u32x4*)(A + off), av); unpack8(*(const u32x4*)(B + off), bv);
#pragma unroll
                for (int n = 0; n < 2; ++n)
#pragma unroll
                    for (int e = 0; e < 4; ++e) o[4 * n + e] = sigm(acc[ai][0][m][n][e]) * av[4 * n + e] + sigm(acc[ai][1][m][n][e]) * bv[4 * n + e];
                *(u32x4*)(O + off) = pack8(o); }
    }
};
struct EpiRes {
    static constexpr bool PERM = false;
    const float* X; float* O; const float* gate;
    __device__ __forceinline__ void operator()(const f32x4 (&acc)[2][2][4][2], const Unit& u, int wr, int wc, int fr, int fq) const {
        const int row0 = u.pm * 256 + wr * 64 + fr, col0 = u.pn * 256 + wc * 32 + 4 * fq;
#pragma unroll
        for (int ai = 0; ai < 2; ++ai)
#pragma unroll
            for (int m = 0; m < 4; ++m) { const int row = row0 + ai * 128 + m * 16; const float* gp = gate + (size_t)(row >> 11) * NMOD + col0;
                const float* xp = X + (size_t)row * DM + col0; float* op = O + (size_t)row * DM + col0;
#pragma unroll
                for (int bj = 0; bj < 2; ++bj)
#pragma unroll
                    for (int n = 0; n < 2; ++n) { const int c = bj * 128 + n * 16; const f32x4 g4 = *(const f32x4*)(gp + c), x4 = *(const f32x4*)(xp + c);
                        *(f32x4*)(op + c) = x4 + g4 * acc[ai][bj][m][n]; } }
    }
};

__device__ __forceinline__ void transpose_item(const float* W, int N, bf16_t* WT, int K, int k0, int src_col0, int dst_row0, LAS float* scr, int lane) {
#pragma unroll 8
    for (int i = 0; i < 32; ++i) { const int kk = 2 * i + (lane >> 5); scr[kk * 33 + (lane & 31)] = W[(size_t)(k0 + kk) * N + src_col0 + (lane & 31)]; }
    WAVE_SYNC();
    const int c = lane & 7;
#pragma unroll
    for (int j = 0; j < 4; ++j) { const int n = (lane >> 3) + 8 * j; const LAS float* s = scr + (8 * c) * 33 + n;
        u32x4 o; o.x = pk2(s[0 * 33], s[1 * 33]); o.y = pk2(s[2 * 33], s[3 * 33]); o.z = pk2(s[4 * 33], s[5 * 33]); o.w = pk2(s[6 * 33], s[7 * 33]);
        *(u32x4*)(WT + (size_t)(dst_row0 + n) * K + k0 + 8 * c) = o; }
    WAVE_SYNC();
}
__device__ __forceinline__ void sincos_d(double x, double& s, double& c) {
    const double k = rint(x * 0.6366197723675814);
    double r = fma(-k, 1.5707963267948966, x); r = fma(-k, 6.123233995736766e-17, r);
    const int q = ((int)k) & 3;
    const double r2 = r * r;
    const double sp = r * (1.0 + r2 * (-1.0 / 6 + r2 * (1.0 / 120 + r2 * (-1.0 / 5040 + r2 * (1.0 / 362880 + r2 * (-1.0 / 39916800 + r2 * (1.0 / 6227020800.0)))))));
    const double cp = 1.0 + r2 * (-0.5 + r2 * (1.0 / 24 + r2 * (-1.0 / 720 + r2 * (1.0 / 40320 + r2 * (-1.0 / 3628800 + r2 * (1.0 / 479001600.0 + r2 * (-1.0 / 87178291200.0)))))));
    s = (q == 0) ? sp : (q == 1) ? cp : (q == 2) ? -sp : -cp;
    c = (q == 0) ? cp : (q == 1) ? -sp : (q == 2) ? -cp : sp;
}
__device__ __forceinline__ double exp_small_d(double x) {
    return 1.0 + x * (1.0 + x * (0.5 + x * (1.0 / 6 + x * (1.0 / 24 + x * (1.0 / 120 + x * (1.0 / 720 + x * (1.0 / 5040 + x * (1.0 / 40320 + x * (1.0 / 362880)))))))));
}

__device__ __forceinline__ void phase_prep(const Args& a, LAS unsigned char* lds, int G, int tid, int wave, int lane) {
    unsigned char* ws = a.ws;
    {
        const float* c = a.in[1]; const float* cctx = a.in[3]; const float* wmod = a.in[4]; const float* bmod = a.in[5];
        float* mod = (float*)(ws + WS_MOD);
        for (int item = blockIdx.x; item < NMOD / 64; item += G) {
            const int j0 = item * 64, kb = wave * 128;
            LAS float* cs = (LAS float*)(lds + wave * 9216);
            for (int i = lane; i < 17 * 128; i += 64) { const int b = i >> 7, k = i & 127; const float v = (b < 16) ? c[b * DM + kb + k] : cctx[kb + k]; cs[i] = v * sigm(v); }
            WAVE_SYNC();
            float acc[17];
#pragma unroll
            for (int b = 0; b < 17; ++b) acc[b] = 0.f;
            for (int k4 = 0; k4 < 32; ++k4) {
                const float* wp = wmod + (size_t)(kb + 4 * k4) * NMOD + j0 + lane;
                const float w0 = wp[0], w1 = wp[NMOD], w2 = wp[2 * NMOD], w3 = wp[3 * NMOD];
#pragma unroll
                for (int b = 0; b < 17; ++b) { const f32x4 cv = *(const LAS f32x4*)(cs + b * 128 + 4 * k4); acc[b] += cv.x * w0 + cv.y * w1 + cv.z * w2 + cv.w * w3; }
            }
            LAS float* red = (LAS float*)(lds + 73728);
#pragma unroll
            for (int b = 0; b < 17; ++b) red[(wave * 17 + b) * 64 + lane] = acc[b];
            __syncthreads();
            for (int o = tid; o < 17 * 64; o += NWAVES * 64) { const int b = o >> 6, l = o & 63; float s = 0.f;
#pragma unroll
                for (int w = 0; w < 8; ++w) s += red[(w * 17 + b) * 64 + l];
                mod[(size_t)b * NMOD + j0 + l] = s + bmod[j0 + l]; }
            __syncthreads();
        }
    }
    __syncthreads();
    {
        LAS float* scr = (LAS float*)(lds + wave * 16384);
        const int nskip = 0;
        const int gw = ((int)blockIdx.x - nskip) * NWAVES + wave, NGW = (G - nskip) * NWAVES;
        constexpr int NI0 = 16 * 136, NI1 = 16 * 64, NI2 = 16 * 64, NI3 = 16 * 32, NI4 = 16 * 32, NI5 = 16 * 176, NI6 = 44 * 32, NI7 = 32, NI11 = 64;
        constexpr int NTOT = NI0 + NI1 + NI2 + NI3 + NI4 + NI5 + NI6 + 4 * NI7 + NI11;
        for (int it = (gw >= 0) ? gw : NTOT; it < NTOT; it += NGW) {
            int r = it; const float* W; bf16_t* WT; int K, Nsrc, Ndst, mode, off, half;
            if (r < NI0) { W = a.in[8]; WT = (bf16_t*)(ws + WS_WIN_A); K = 1024; Nsrc = 6400; Ndst = 4352; mode = 0; off = 0; half = 0; }
            else if ((r -= NI0) < NI1) { W = a.in[8]; WT = (bf16_t*)(ws + WS_WIN_G); K = 1024; Nsrc = 6400; Ndst = 2048; mode = 1; off = 4352; half = 1024; }
            else if ((r -= NI1) < NI2) { W = a.in[17]; WT = (bf16_t*)(ws + WS_WGLU); K = 1024; Nsrc = 2048; Ndst = 2048; mode = 1; off = 0; half = 1024; }
            else if ((r -= NI2) < NI3) { W = a.in[29]; WT = (bf16_t*)(ws + WS_WROUT); K = 1024; Nsrc = 1024; Ndst = 1024; mode = 0; off = 0; half = 0; }
            else if ((r -= NI3) < NI4) { W = a.in[30]; WT = (bf16_t*)(ws + WS_WOUT); K = 1024; Nsrc = 1024; Ndst = 1024; mode = 0; off = 0; half = 0; }
            else if ((r -= NI4) < NI5) { W = a.in[31]; WT = (bf16_t*)(ws + WS_WUP); K = 1024; Nsrc = 5632; Ndst = 5632; mode = 1; off = 0; half = 2816; }
            else if ((r -= NI5) < NI6) { W = a.in[34]; WT = (bf16_t*)(ws + WS_WDOWN); K = 2816; Nsrc = 1024; Ndst = 1024; mode = 0; off = 0; half = 0; }
            else if ((r -= NI6) < 2 * NI7) { const int d = r / NI7; r -= d * NI7; W = a.in[20] + (size_t)d * 64 * 1024; WT = (bf16_t*)(ws + WS_WUPT) + (size_t)d * 1024 * 64; K = 64; Nsrc = 1024; Ndst = 1024; mode = 0; off = 0; half = 0; }
            else if ((r -= 2 * NI7) < 2 * NI7) { const int d = r / NI7; r -= d * NI7; W = a.in[22] + (size_t)d * 64 * 1024; WT = (bf16_t*)(ws + WS_AUPT) + (size_t)d * 1024 * 64; K = 64; Nsrc = 1024; Ndst = 1024; mode = 0; off = 0; half = 0; }
            else { r -= 2 * NI7; W = a.in[23]; WT = (bf16_t*)(ws + WS_GUPT); K = 128; Nsrc = 1024; Ndst = 1024; mode = 0; off = 0; half = 0; }
            const int nblk = Ndst / 32, kb = r / nblk, nb = r % nblk, dr0 = 32 * nb;
            const int sc0 = mode ? (off + ((dr0 & 255) >> 7) * half + 128 * (dr0 >> 8) + (dr0 & 127)) : (off + dr0);
            transpose_item(W, Nsrc, WT, K, 64 * kb, sc0, dr0, scr, lane);
        }
    }
    {
        float* LAM = (float*)(ws + WS_LAM); bf16_t* BBT = (bf16_t*)(ws + WS_BBT); bf16_t* CT = (bf16_t*)(ws + WS_CT);
        const float* are = a.in[9]; const float* aim = a.in[10]; const float* ldt = a.in[11]; const float* bre = a.in[12]; const float* bim = a.in[13];
        const float* cre = a.in[14]; const float* cim = a.in[15];
        for (int idx = blockIdx.x * (NWAVES * 64) + tid; idx < 2 * 64 * 64; idx += G * NWAVES * 64) {
            const int dg = idx >> 6, p = idx & 63;
            const double ar = (double)are[idx], ai = (double)aim[idx];
            const double dtd = exp((double)ldt[dg]);
            const double mag = exp_small_d(ar * dtd);
            double sn, cs; sincos_d(ai * dtd, sn, cs);
            const double lr = mag * cs, li = mag * sn;
            const double den = ar * ar + ai * ai;
            const double cr = ((lr - 1.0) * ar + li * ai) / den, ci = (li * ar - (lr - 1.0) * ai) / den;
            LAM[2 * idx] = (float)lr; LAM[2 * idx + 1] = (float)li;
#pragma unroll
            for (int c = 0; c < 16; ++c) { const double br = (double)bre[(size_t)idx * 16 + c], bi = (double)bim[(size_t)idx * 16 + c];
#ifdef OLD_S5
                BBT[((size_t)dg * 128 + p) * 16 + c] = f2bf((float)(cr * br - ci * bi));
                BBT[((size_t)dg * 128 + 64 + p) * 16 + c] = f2bf((float)(cr * bi + ci * br)); }
#else
                BBT[((size_t)dg * 128 + 2 * p) * 16 + c] = f2bf((float)(cr * br - ci * bi));
                BBT[((size_t)dg * 128 + 2 * p + 1) * 16 + c] = f2bf((float)(cr * bi + ci * br)); }
#endif
#pragma unroll
            for (int c = 0; c < 16; ++c) { const size_t si = ((size_t)dg * 16 + c) * 64 + p;
#ifdef OLD_S5
                CT[((size_t)dg * 16 + c) * 128 + p] = f2bf(cre[si]); CT[((size_t)dg * 16 + c) * 128 + 64 + p] = f2bf(-cim[si]); }
#else
                CT[((size_t)dg * 16 + c) * 128 + 2 * p] = f2bf(cre[si]); CT[((size_t)dg * 16 + c) * 128 + 2 * p + 1] = f2bf(-cim[si]); }
#endif
        }
    }
}

__device__ __forceinline__ void norm_mod_rows(const float* src_lat, const float* src_ctx, int nrows, const float* mod, int sh_off, int sc_off, const float* gain, bf16_t* out, int gw, int NGW, int lane) {
    const int rows_per = (nrows + NGW - 1) / NGW;
    int m = gw * rows_per; const int mend = (m + rows_per < nrows) ? (m + rows_per) : nrows;
    if (m >= mend) return;
    f32x4 vn[4];
    { const float* row = (m < T) ? src_lat + (size_t)m * DM : src_ctx + (size_t)(m - T) * DM; const f32x4* xr = (const f32x4*)row + lane;
#pragma unroll
      for (int j = 0; j < 4; ++j) vn[j] = xr[64 * j]; }
    f32x4 g[4], sh[4], sc[4]; int b_loaded = -1;
    { const f32x4* g4 = (const f32x4*)gain + lane;
#pragma unroll
      for (int j = 0; j < 4; ++j) { g[j] = g4[64 * j]; sh[j] = g[j]; sc[j] = g[j]; } }
    for (; m < mend; ++m) {
        f32x4 v[4];
#pragma unroll
        for (int j = 0; j < 4; ++j) v[j] = vn[j];
        const int mn = m + 1;
        if (mn < mend) { const float* row = (mn < T) ? src_lat + (size_t)mn * DM : src_ctx + (size_t)(mn - T) * DM; const f32x4* xr = (const f32x4*)row + lane;
#pragma unroll
            for (int j = 0; j < 4; ++j) vn[j] = xr[64 * j]; }
        const int b = (m < T) ? (m >> 11) : 16;
        if (b != b_loaded) { b_loaded = b; const f32x4* sh4 = (const f32x4*)(mod + (size_t)b * NMOD + sh_off) + lane; const f32x4* sc4 = (const f32x4*)(mod + (size_t)b * NMOD + sc_off) + lane;
#pragma unroll
            for (int j = 0; j < 4; ++j) { sh[j] = sh4[64 * j]; sc[j] = 1.f + sc4[64 * j]; } }
        float s = 0.f;
#pragma unroll
        for (int j = 0; j < 4; ++j) s += (v[j].x * v[j].x + v[j].y * v[j].y) + (v[j].z * v[j].z + v[j].w * v[j].w);
        const float inv = rsqrtf(wave_sum(s) * (1.f / DM) + 1e-6f);
        u32x2* o8 = (u32x2*)(out + (size_t)m * DM) + lane;
#pragma unroll
        for (int j = 0; j < 4; ++j) { const f32x4 h = v[j] * inv * g[j] * sc[j] + sh[j];
            u32x2 o; o.x = pk2(h.x, h.y); o.y = pk2(h.z, h.w); o8[64 * j] = o; }
    }
}
__device__ __forceinline__ void final_norm_rows(float* io, const float* gain, int gw, int NGW, int lane) {
    int m = gw;
    if (m >= T) return;
    f32x4 vn[4];
    { const f32x4* xr = (const f32x4*)(io + (size_t)m * DM) + lane;
#pragma unroll
      for (int j = 0; j < 4; ++j) vn[j] = xr[64 * j]; }
    const f32x4* g4 = (const f32x4*)gain + lane;
    f32x4 gg[4];
#pragma unroll
    for (int j = 0; j < 4; ++j) gg[j] = g4[64 * j];
    for (; m < T; m += NGW) {
        f32x4 v[4];
#pragma unroll
        for (int j = 0; j < 4; ++j) v[j] = vn[j];
        const int mn = m + NGW;
        if (mn < T) { const f32x4* xr = (const f32x4*)(io + (size_t)mn * DM) + lane;
#pragma unroll
            for (int j = 0; j < 4; ++j) vn[j] = xr[64 * j]; }
        float s = 0.f;
#pragma unroll
        for (int j = 0; j < 4; ++j) s += (v[j].x * v[j].x + v[j].y * v[j].y) + (v[j].z * v[j].z + v[j].w * v[j].w);
        const float inv = rsqrtf(wave_sum(s) * (1.f / DM) + 1e-6f);
        f32x4* xo = (f32x4*)(io + (size_t)m * DM) + lane;
#pragma unroll
        for (int j = 0; j < 4; ++j) xo[64 * j] = v[j] * inv * gg[j];
    }
}

__device__ __forceinline__ void nb_of(int type, int t, int& delta, bool& valid) {
    if (type == 0) { delta = -1; valid = (t & 63) != 0; }
    else if (type == 1) { delta = 1; valid = (t & 63) != 63; }
    else if (type == 2) { delta = -64; valid = t >= 64; }
    else if (type == 3) { delta = 64; valid = t < SEQ - 64; }
    else if (type == 4) { delta = -1; valid = t > 0; }
    else { delta = 1; valid = t < CTXL - 1; }
}
template <class MuPtr>
__device__ __forceinline__ void load_lerp16(const bf16_t* rw, size_t m, int col, int delta, bool valid, MuPtr mu, float* out) {
    const u32x4* p = (const u32x4*)(rw + m * RWC + col);
    const u32x4 a0 = p[0], a1 = p[1];
    u32x4 n0 = (u32x4){0u, 0u, 0u, 0u}, n1 = n0;
    if (valid) { const u32x4* q = (const u32x4*)(rw + (size_t)((long)m + delta) * RWC + col); n0 = q[0]; n1 = q[1]; }
    float x[16], nb[16];
    unpack8(a0, x); unpack8(a1, x + 8); unpack8(n0, nb); unpack8(n1, nb + 8);
#pragma unroll
    for (int e = 0; e < 16; ++e) out[e] = x[e] + (nb[e] - x[e]) * mu[e];
}
template <class MuPtr>
__device__ __forceinline__ void load_lerp8(const bf16_t* rw, size_t m, int col, int delta, bool valid, MuPtr mu, float* out) {
    const u32x4 a0 = *(const u32x4*)(rw + m * RWC + col);
    u32x4 n0 = (u32x4){0u, 0u, 0u, 0u};
    if (valid) n0 = *(const u32x4*)(rw + (size_t)((long)m + delta) * RWC + col);
    float x[8], nb[8];
    unpack8(a0, x); unpack8(n0, nb);
#pragma unroll
    for (int e = 0; e < 8; ++e) out[e] = x[e] + (nb[e] - x[e]) * mu[e];
}

__device__ __forceinline__ void chunk_rows(int ci, int d, int b, bool& is_ctx, int& t0, size_t& rowbase) {
    is_ctx = ci < 16;
    if (is_ctx) { const int c = d ? 15 - ci : ci; t0 = 16 * c; rowbase = (size_t)T + (size_t)b * CTXL + t0; }
    else { const int c = d ? 127 - (ci - 16) : (ci - 16); t0 = 16 * c; rowbase = (size_t)b * SEQ + t0; }
}

#define XB_TMO      128
#define XB_XCNT(j)  (256  + 64 * (j))
#define XB_XSUB(j)  (1280 + 64 * (j))
#define XB_XGEN(j)  (2304 + 64 * (j))
#define XB_TOP      3328
#define XB_TOPGEN   3392
#define XCD_BAR_WORDS 3456
#define XB_SPIN_CAP (1u << 20)
__device__ __forceinline__ unsigned xb_ld(unsigned* p)              { return __hip_atomic_load(p, __ATOMIC_RELAXED, __HIP_MEMORY_SCOPE_AGENT); }
__device__ __forceinline__ unsigned xb_add(unsigned* p, unsigned v) { return __hip_atomic_fetch_add(p, v, __ATOMIC_RELAXED, __HIP_MEMORY_SCOPE_AGENT); }
__device__ __forceinline__ unsigned xb_xcc_id() { return (unsigned)__builtin_amdgcn_s_getreg((3 << 11) | 20) & 0xFu; }
#define XB_SPIN(cond, bar) do { unsigned _sp = 0; while (cond) { __builtin_amdgcn_s_sleep(1); \
    if ((++_sp & 255u) == 0u) { if (xb_ld(&(bar)[XB_TMO])) break; if (_sp > XB_SPIN_CAP) { atomicAdd(&(bar)[XB_TMO], 1u); break; } } } } while (0)
struct XcdBarrier { unsigned* bar; unsigned x; volatile LAS unsigned* st; };
__device__ __forceinline__ XcdBarrier xcd_barrier_post(unsigned* bar, volatile LAS unsigned* st) {
    XcdBarrier b; b.bar = bar; b.x = xb_xcc_id(); b.st = st;
    if (threadIdx.x == 0) (void)xb_add(&bar[XB_XCNT(b.x)], 1u);
    return b;
}
__device__ __forceinline__ void xcd_barrier_complete(unsigned* bar, unsigned x, unsigned& nloc, unsigned& nx) {
    const unsigned G = gridDim.x * gridDim.y * gridDim.z;
    unsigned sum, cnt, mine, sp = 0u;
    for (;;) {
        sum = 0u; cnt = 0u; mine = 0u;
#pragma unroll
        for (unsigned j = 0; j < 16; ++j) { const unsigned c = xb_ld(&bar[XB_XCNT(j)]); sum += c; cnt += (c > 0u) ? 1u : 0u; mine = (j == x) ? c : mine; }
        if (sum == G) break;
        __builtin_amdgcn_s_sleep(1);
        if ((++sp & 255u) == 0u) { if (xb_ld(&bar[XB_TMO])) break; if (sp > XB_SPIN_CAP) { atomicAdd(&bar[XB_TMO], 1u); break; } }
    }
    nloc = mine > 0u ? mine : 1u; nx = cnt > 0u ? cnt : 1u;
}
__device__ __forceinline__ void xcd_barrier(const XcdBarrier& b) {
    asm volatile("s_waitcnt vmcnt(0)" ::: "memory");
    __syncthreads();
    if (threadIdx.x == 0) {
        unsigned* bar = b.bar;
        __builtin_amdgcn_s_waitcnt(0);
        unsigned nloc = b.st[0], nx = b.st[1];
        if (nloc == 0u) { xcd_barrier_complete(bar, b.x, nloc, nx); b.st[0] = nloc; b.st[1] = nx; }
        const unsigned old = xb_add(&bar[XB_XSUB(b.x)], 1u);
        const unsigned gen = old / nloc;
        if (old + 1u == (gen + 1u) * nloc) {
            __builtin_amdgcn_fence(__ATOMIC_RELEASE, "agent");
            asm volatile("s_waitcnt vmcnt(0)" ::: "memory");
            const unsigned og = xb_add(&bar[XB_TOP], 1u);
            const unsigned tg = og / nx;
            if (og + 1u == (tg + 1u) * nx) xb_add(&bar[XB_TOPGEN], 1u);
            else XB_SPIN(xb_ld(&bar[XB_TOPGEN]) == tg, bar);
            __builtin_amdgcn_fence(__ATOMIC_ACQUIRE, "agent");
            xb_add(&bar[XB_XGEN(b.x)], 1u);
            asm volatile("s_waitcnt vmcnt(0)" ::: "memory");
        } else {
            XB_SPIN(xb_ld(&bar[XB_XGEN(b.x)]) == gen, bar);
            __builtin_amdgcn_fence(__ATOMIC_ACQUIRE, "agent");
            asm volatile("s_waitcnt vmcnt(0)" ::: "memory");
        }
    }
    __syncthreads();
}
#ifndef SCAN_UNROLL
#define SCAN_UNROLL 16
#endif
constexpr int OPS = 196;
constexpr int O_BKD = 64, O_A = 128, O_R = 160;
constexpr int VS = 68;
constexpr int YS = 36;
constexpr int SLOT_F = 16 * OPS + 16 * VS;
constexpr int NSLOT = 3;
constexpr int P3_RING = 0, P3_YB = 2 * NSLOT * SLOT_F * 4, P3_CST = P3_YB + 4 * 16 * YS * 4, P3_FLG = P3_CST + 4 * 2560, P3_ZERO = P3_FLG + 64, P3_END = P3_ZERO + 256, P3_S5_BYTES = 12800;
static_assert(P3_END <= LDS_BYTES - 64 && 4 * P3_S5_BYTES <= LDS_BYTES - 64, "P3 LDS maps");

__device__ __forceinline__ unsigned flag_ld(volatile LAS unsigned* p) { return (unsigned)__builtin_amdgcn_readfirstlane((int)*p); }
__device__ __forceinline__ void spin_ge(volatile LAS unsigned* p, unsigned need) {
    while (flag_ld(p) < need) __builtin_amdgcn_s_sleep(1);
    asm volatile("" ::: "memory");
}

struct Raw16 { u32x4 a0, a1, n0, n1; bool ok; };
struct Raw8 { u32x4 a0, n0; bool ok; };
__device__ __forceinline__ Raw16 ld_raw16(const bf16_t* rw, size_t m, int col, int delta, bool valid) {
    Raw16 r; const u32x4* p = (const u32x4*)(rw + m * RWC + col); const u32x4* q = (const u32x4*)(rw + (size_t)((long)m + (valid ? delta : 0)) * RWC + col);
    r.a0 = p[0]; r.a1 = p[1]; r.n0 = q[0]; r.n1 = q[1]; r.ok = valid; return r;
}
__device__ __forceinline__ Raw8 ld_raw8(const bf16_t* rw, size_t m, int col, int delta, bool valid) {
    Raw8 r; r.a0 = *(const u32x4*)(rw + m * RWC + col); r.n0 = *(const u32x4*)(rw + (size_t)((long)m + (valid ? delta : 0)) * RWC + col); r.ok = valid; return r;
}
template <class MuPtr> __device__ __forceinline__ void lerp16(const Raw16& r, MuPtr mu, float* out) {
    const u32x4 z = (u32x4){0u, 0u, 0u, 0u};
    float x[16], nb[16]; unpack8(r.a0, x); unpack8(r.a1, x + 8); unpack8(r.ok ? r.n0 : z, nb); unpack8(r.ok ? r.n1 : z, nb + 8);
#pragma unroll
    for (int e = 0; e < 16; ++e) out[e] = x[e] + (nb[e] - x[e]) * mu[e];
}
template <class MuPtr> __device__ __forceinline__ void lerp8(const Raw8& r, MuPtr mu, float* out) {
    const u32x4 z = (u32x4){0u, 0u, 0u, 0u};
    float x[8], nb[8]; unpack8(r.a0, x); unpack8(r.ok ? r.n0 : z, nb);
#pragma unroll
    for (int e = 0; e < 8; ++e) out[e] = x[e] + (nb[e] - x[e]) * mu[e];
}

__device__ __forceinline__ void wkv_prep_wave(const Args& a, LAS float* ring, LAS float* cst, volatile LAS unsigned* ready, volatile LAS unsigned* done0, volatile LAS unsigned* done1,
                                              int chain, unsigned seq0, int parity, int cstep, int lane) {
    unsigned char* ws = a.ws;
    const bf16_t* rw = (const bf16_t*)(ws + WS_RW);
    const int d = chain & 1, h = (chain >> 1) & 15, b = chain >> 5;
    float* BETA = (float*)(ws + WS_BETA);
    {
        const float* mu = a.in[18];
        cst[0 * 64 + lane] = mu[64 * h + lane]; cst[1 * 64 + lane] = mu[1024 + 64 * h + lane]; cst[2 * 64 + lane] = mu[2048 + 64 * h + lane];
        cst[3 * 64 + lane] = a.in[24][64 * h + lane]; cst[4 * 64 + lane] = a.in[25][64 * h + lane]; cst[5 * 64 + lane] = a.in[26][(d * 16 + h) * 64 + lane];
        cst[6 * 64 + lane] = a.in[19][d * 1024 + 64 * h + lane]; cst[7 * 64 + lane] = a.in[21][d * 1024 + 64 * h + lane];
        cst[8 * 64 + lane] = mu[3072 + lane]; cst[9 * 64 + lane] = mu[3136 + lane];
    }
    WAVE_SYNC();
    const int tk = lane & 15, sg = lane >> 4;
    bf16x8 WUP[4][2], AUP[4][2];
    {
        const bf16_t* wupt = (const bf16_t*)(ws + WS_WUPT) + (size_t)d * 1024 * 64; const bf16_t* aupt = (const bf16_t*)(ws + WS_AUPT) + (size_t)d * 1024 * 64;
#pragma unroll
        for (int nt = 0; nt < 4; ++nt)
#pragma unroll
            for (int ks = 0; ks < 2; ++ks) { const int n = 64 * h + 16 * (tk >> 2) + 4 * nt + (tk & 3);
                WUP[nt][ks] = *(const bf16x8*)(wupt + (size_t)n * 64 + 32 * ks + 8 * sg); AUP[nt][ks] = *(const bf16x8*)(aupt + (size_t)n * 64 + 32 * ks + 8 * sg); }
    }
    for (int ci = parity; ci < 144; ci += cstep) {
        bool is_ctx; int t0; size_t rowbase; chunk_rows(ci, d, b, is_ctx, t0, rowbase);
        const int type_r = is_ctx ? 4 : (h < 13 ? 0 : 1), type_k = is_ctx ? (h < 10 ? 4 : 5) : (h < 10 ? 1 : 2), type_v = is_ctx ? 5 : (h < 7 ? 2 : 3), type_w = is_ctx ? 5 : 3;
        const int t = t0 + tk; const size_t m = rowbase + tk;
        int dl; bool vd;
        nb_of(type_w, t, dl, vd);
        const Raw8 rwd0 = ld_raw8(rw, m, 3072 + 8 * sg, dl, vd), rwd1 = ld_raw8(rw, m, 3072 + 32 + 8 * sg, dl, vd);
        const Raw8 rad0 = ld_raw8(rw, m, 3136 + 8 * sg, dl, vd), rad1 = ld_raw8(rw, m, 3136 + 32 + 8 * sg, dl, vd);
        nb_of(type_k, t, dl, vd); const Raw16 rk = ld_raw16(rw, m, 1024 + 64 * h + 16 * sg, dl, vd);
        nb_of(type_r, t, dl, vd); const Raw16 rr = ld_raw16(rw, m, 64 * h + 16 * sg, dl, vd);
        bf16x8 wfr[2], afr[2];
        { float xw[8], xa[8];
          lerp8(rwd0, cst + 8 * 64 + 8 * sg, xw); lerp8(rad0, cst + 9 * 64 + 8 * sg, xa);
#pragma unroll
          for (int e = 0; e < 8; ++e) xw[e] = tanh_(xw[e]);
          wfr[0] = as_bf16x8(pack8(xw)); afr[0] = as_bf16x8(pack8(xa));
          lerp8(rwd1, cst + 8 * 64 + 32 + 8 * sg, xw); lerp8(rad1, cst + 9 * 64 + 32 + 8 * sg, xa);
#pragma unroll
          for (int e = 0; e < 8; ++e) xw[e] = tanh_(xw[e]);
          wfr[1] = as_bf16x8(pack8(xw)); afr[1] = as_bf16x8(pack8(xa)); }
        nb_of(type_v, t, dl, vd); const Raw16 rv = ld_raw16(rw, m, 2048 + 64 * h + 16 * sg, dl, vd);
        f32x4 accw[4], acca[4];
#pragma unroll
        for (int nt = 0; nt < 4; ++nt) { accw[nt] = (f32x4){0.f, 0.f, 0.f, 0.f}; acca[nt] = accw[nt];
#pragma unroll
            for (int ks = 0; ks < 2; ++ks) { accw[nt] = __builtin_amdgcn_mfma_f32_16x16x32_bf16(WUP[nt][ks], wfr[ks], accw[nt], 0, 0, 0);
                acca[nt] = __builtin_amdgcn_mfma_f32_16x16x32_bf16(AUP[nt][ks], afr[ks], acca[nt], 0, 0, 0); } }
        const unsigned seq = seq0 + (unsigned)ci;
        if (seq >= (unsigned)NSLOT) { spin_ge(done0, seq - (unsigned)NSLOT + 1u); spin_ge(done1, seq - (unsigned)NSLOT + 1u); }
        LAS float* slot = ring + (seq % (unsigned)NSLOT) * SLOT_F;
        LAS float* ow = slot + tk * OPS + 16 * sg;
        float aa[16];
        { float dec[16];
#pragma unroll
          for (int e = 0; e < 16; ++e) { const float x = cst[6 * 64 + 16 * sg + e] + accw[e >> 2][e & 3];
              dec[e] = __expf(-0.6065306597126334f * sigm(x));
              aa[e] = sigm(cst[7 * 64 + 16 * sg + e] + acca[e >> 2][e & 3]); }
#pragma unroll
          for (int q = 0; q < 4; ++q) *(LAS f32x4*)(ow + 0 * 64 + 4 * q) = (f32x4){dec[4 * q], dec[4 * q + 1], dec[4 * q + 2], dec[4 * q + 3]}; }
        float kd[16];
        { float xk[16], kk[16]; float ssq = 0.f;
          lerp16(rk, cst + 1 * 64 + 16 * sg, xk);
#pragma unroll
          for (int e = 0; e < 16; ++e) { kk[e] = xk[e] * cst[3 * 64 + 16 * sg + e]; ssq += kk[e] * kk[e]; kd[e] = xk[e] * (1.f + (aa[e] - 1.f) * cst[4 * 64 + 16 * sg + e]); }
          ssq += __shfl_xor(ssq, 16); ssq += __shfl_xor(ssq, 32);
          const float inv = rsqrtf(fmaxf(ssq, 1e-24f));
          { float na[16];
#pragma unroll
            for (int e = 0; e < 16; ++e) { kk[e] *= inv; na[e] = -kk[e]; }
            LAS u32x4* ab = (LAS u32x4*)(slot + tk * OPS + O_A + 8 * sg);
            ab[0] = pack8(na); ab[1] = pack8(na + 8); }
#pragma unroll
          for (int q = 0; q < 4; ++q) { u32x4 w4;
              w4.x = pk2(kk[4 * q] * aa[4 * q], kd[4 * q]); w4.y = pk2(kk[4 * q + 1] * aa[4 * q + 1], kd[4 * q + 1]); w4.z = pk2(kk[4 * q + 2] * aa[4 * q + 2], kd[4 * q + 2]); w4.w = pk2(kk[4 * q + 3] * aa[4 * q + 3], kd[4 * q + 3]);
              *(LAS u32x4*)(ow + O_BKD + 4 * q) = w4; } }
        { float xr[16]; float bet = 0.f;
          lerp16(rr, cst + 0 * 64 + 16 * sg, xr);
#pragma unroll
          for (int e = 0; e < 16; ++e) bet += xr[e] * kd[e] * cst[5 * 64 + 16 * sg + e];
          bet += __shfl_xor(bet, 16); bet += __shfl_xor(bet, 32);
          LAS u32x4* rb = (LAS u32x4*)(slot + tk * OPS + O_R + 8 * sg);
          rb[0] = pack8(xr); rb[1] = pack8(xr + 8);
          if (!is_ctx && sg == 0) BETA[((size_t)d * T + m) * 16 + h] = bet; }
        { float xv[16];
          lerp16(rv, cst + 2 * 64 + 16 * sg, xv);
#pragma unroll
          for (int q = 0; q < 4; ++q) *(LAS f32x4*)(slot + 16 * OPS + tk * VS + 16 * sg + 4 * q) = (f32x4){xv[4 * q], xv[4 * q + 1], xv[4 * q + 2], xv[4 * q + 3]}; }
        WAVE_SYNC();
        spin_ge(ready, seq);
        if (lane == 0) *ready = seq + 1u;
        asm volatile("" ::: "memory");
    }
}

struct WkvOps { f32x4 w4[4]; unsigned bk[4]; float v0, v1; u32x4 af[2]; };
__device__ __forceinline__ WkvOps wkv_load_ops(const LAS float* ob, const LAS float* vrow, const LAS float* xsrc, const LAS float* fsrc, int kq) {
    WkvOps o;
#pragma unroll
    for (int kt = 0; kt < 4; ++kt) { o.w4[kt] = *(const LAS f32x4*)(ob + 16 * kt + 4 * kq); o.bk[kt] = *(const LAS unsigned*)(xsrc + 16 * kt); }
    o.v0 = vrow[0]; o.v1 = vrow[16];
#pragma unroll
    for (int ks = 0; ks < 2; ++ks) { const u32x2 lo = *(const LAS u32x2*)(fsrc + 16 * ks + 2 * kq), hi = *(const LAS u32x2*)(fsrc + 16 * ks + 8 + 2 * kq);
        o.af[ks] = (u32x4){lo.x, lo.y, hi.x, hi.y}; }
    return o;
}
__device__ __forceinline__ void wkv_scan_wave(const Args& a, LAS float* ring, LAS float* yb, const LAS float* zline, volatile LAS unsigned* ready, volatile LAS unsigned* done, int chain, int hw, unsigned seq0, int lane) {
    const int d = chain & 1, h = (chain >> 1) & 15, b = chain >> 5;
    bf16_t* Yd = (bf16_t*)a.out + (size_t)d * T * DM;
    const int vi = lane & 15, kq = lane >> 4, role = vi & 3;
    f32x4 Tt[4][2];
#pragma unroll
    for (int i = 0; i < 4; ++i)
#pragma unroll
        for (int j = 0; j < 2; ++j) Tt[i][j] = (f32x4){0.f, 0.f, 0.f, 0.f};
    u32x4 rl[2] = {(u32x4){0u, 0u, 0u, 0u}, (u32x4){0u, 0u, 0u, 0u}};
    bool prev_lat = false; size_t prev_rowbase = 0;
    const int ftok = lane >> 2, fpc = lane & 3;
#define WKV_FLUSH(RB) do { WAVE_SYNC(); \
        const f32x4 y0 = *(const LAS f32x4*)(yb + ftok * YS + 8 * fpc), y1 = *(const LAS f32x4*)(yb + ftok * YS + 8 * fpc + 4); \
        u32x4 o; o.x = pk2(y0.x, y0.y); o.y = pk2(y0.z, y0.w); o.z = pk2(y1.x, y1.y); o.w = pk2(y1.z, y1.w); \
        *(u32x4*)(Yd + ((RB) + ftok) * DM + 64 * h + 32 * hw + 8 * fpc) = o; WAVE_SYNC(); } while (0)
#define WKV_PASS(AF, SA, YV) do { _Pragma("unroll") for (int rt = 0; rt < 2; ++rt) { f32x4 acc = (f32x4){0.f, 0.f, 0.f, 0.f}; \
            _Pragma("unroll") for (int ks = 0; ks < 2; ++ks) { u32x4 sb; sb.x = pk2(Tt[2 * ks][rt].x, Tt[2 * ks][rt].y); sb.y = pk2(Tt[2 * ks][rt].z, Tt[2 * ks][rt].w); sb.z = pk2(Tt[2 * ks + 1][rt].x, Tt[2 * ks + 1][rt].y); sb.w = pk2(Tt[2 * ks + 1][rt].z, Tt[2 * ks + 1][rt].w); \
                acc = __builtin_amdgcn_mfma_f32_16x16x32_bf16(as_bf16x8((AF)[ks]), as_bf16x8(sb), acc, 0, 0, 0); } \
            SA[rt] = acc[0]; YV[rt] = acc[1]; } } while (0)
#define WKV_FSRC(OBC, OBP) ((role == 0) ? ((OBC) + O_A) : ((role == 1) ? ((OBP) + O_R) : zline))
#define WKV_XSRC(OBC) ((OBC) + O_BKD + 4 * kq + (vi & 3))
    for (int ci = 0; ci < 144; ++ci) {
        bool is_ctx; int t0; size_t rowbase; chunk_rows(ci, d, b, is_ctx, t0, rowbase);
        const unsigned seq = seq0 + (unsigned)ci;
        spin_ge(ready, seq + 1u);
        const LAS float* slot = ring + (seq % (unsigned)NSLOT) * SLOT_F;
        const LAS float* vbase = slot + 16 * OPS + 32 * hw + vi;
        const int tok0 = d ? 15 : 0;
        WkvOps cur = wkv_load_ops(slot + tok0 * OPS, vbase + tok0 * VS, WKV_XSRC(slot + tok0 * OPS), (role == 0) ? (slot + tok0 * OPS + O_A) : zline, kq);
        if (role == 1) { cur.af[0] = rl[0]; cur.af[1] = rl[1]; }
#pragma unroll SCAN_UNROLL
        for (int s = 0; s < 16; ++s) {
            const int tok = d ? 15 - s : s;
            const LAS float* ob = slot + tok * OPS;
            WkvOps nxt = cur;
            if (s < 15) { const int tn = d ? tok - 1 : tok + 1; nxt = wkv_load_ops(slot + tn * OPS, vbase + tn * VS, WKV_XSRC(slot + tn * OPS), WKV_FSRC(slot + tn * OPS, ob), kq); }
            __builtin_amdgcn_sched_barrier(0);
            float sa[2], yv[2];
            WKV_PASS(cur.af, sa, yv);
            if (s == 0) { if (prev_lat) { if (kq == 0) { const int pt = d ? 0 : 15; yb[pt * YS + vi] = yv[0]; yb[pt * YS + 16 + vi] = yv[1]; } WKV_FLUSH(prev_rowbase); } }
            else if (!is_ctx) { if (kq == 0) { const int pt = d ? tok + 1 : tok - 1; yb[pt * YS + vi] = yv[0]; yb[pt * YS + 16 + vi] = yv[1]; } }
            typedef short bf16x4_t __attribute__((ext_vector_type(4)));
            u32x2 yf[2];
#pragma unroll
            for (int rt = 0; rt < 2; ++rt) { const unsigned pr = pk2(sa[rt], rt ? cur.v1 : cur.v0); yf[rt] = (u32x2){pr, 0u}; }
#pragma unroll
            for (int kt = 0; kt < 4; ++kt) { const u32x2 xf = (u32x2){cur.bk[kt], 0u};
#pragma unroll
                for (int rt = 0; rt < 2; ++rt) { const f32x4 c = Tt[kt][rt] * cur.w4[kt];
                    Tt[kt][rt] = __builtin_amdgcn_mfma_f32_4x4x4bf16_1k(__builtin_bit_cast(bf16x4_t, xf), __builtin_bit_cast(bf16x4_t, yf[rt]), c, 0, 0, 0); } }
            cur = nxt;
        }
        { const LAS float* fs = (role == 1) ? (slot + (d ? 0 : 15) * OPS + O_R) : zline;
#pragma unroll
          for (int ks = 0; ks < 2; ++ks) { const u32x2 lo = *(const LAS u32x2*)(fs + 16 * ks + 2 * kq), hi = *(const LAS u32x2*)(fs + 16 * ks + 8 + 2 * kq); rl[ks] = (u32x4){lo.x, lo.y, hi.x, hi.y}; } }
        WAVE_SYNC();
        if (lane == 0) *done = seq + 1u;
        asm volatile("" ::: "memory");
        prev_lat = !is_ctx; prev_rowbase = rowbase;
    }
    {
        u32x4 af[2];
        af[0] = (role == 1) ? rl[0] : (u32x4){0u, 0u, 0u, 0u}; af[1] = (role == 1) ? rl[1] : (u32x4){0u, 0u, 0u, 0u};
        float sa[2], yv[2];
        WKV_PASS(af, sa, yv); (void)sa;
        if (kq == 0) { const int pt = d ? 0 : 15; yb[pt * YS + vi] = yv[0]; yb[pt * YS + 16 + vi] = yv[1]; }
        WKV_FLUSH(prev_rowbase);
    }
#undef WKV_FLUSH
#undef WKV_PASS
#undef WKV_FSRC
#undef WKV_XSRC
}

constexpr int BUS = 132;
constexpr int HS = 136;
__device__ __forceinline__ void s5_chain(const Args& a, LAS float* buL, LAS bf16_t* HL, int chain, int lane) {
    unsigned char* ws = a.ws;
    const int d = chain & 1, g = (chain >> 1) & 63, b = chain >> 7;
    const bf16_t* U = (const bf16_t*)(ws + WS_U); bf16_t* PO = (bf16_t*)(ws + WS_YG);
    const bf16_t* ESRC = d ? (const bf16_t*)PO : U;
    const float* LAM = (const float*)(ws + WS_LAM); const bf16_t* BBT = (const bf16_t*)(ws + WS_BBT); const bf16_t* CT = (const bf16_t*)(ws + WS_CT);
    const int fr = lane & 15, fq = lane >> 4;
    const int dg = d * 64 + g;
    const f32x4 s5d = *(const f32x4*)(a.in[16] + g * 16 + 4 * fq);
    const float lr = LAM[2 * (dg * 64 + lane)], li = LAM[2 * (dg * 64 + lane) + 1];
    typedef short bf16x4_t __attribute__((ext_vector_type(4)));
    bf16x4_t bfr[8]; bf16x8 cfr[4];
#pragma unroll
    for (int nt = 0; nt < 8; ++nt) bfr[nt] = __builtin_bit_cast(bf16x4_t, *(const u32x2*)(BBT + ((size_t)dg * 128 + 16 * nt + fr) * 16 + 4 * fq));
#pragma unroll
    for (int ks = 0; ks < 4; ++ks) cfr[ks] = *(const bf16x8*)(CT + ((size_t)dg * 16 + fr) * 128 + 32 * ks + 8 * fq);
    float hr = 0.f, hi = 0.f;
    u32x2 uvn[4]; u32x2 en[4];
#pragma unroll
    for (int j = 0; j < 4; ++j) { bool ic; int t0; size_t rb; chunk_rows(j, d, b, ic, t0, rb); uvn[j] = *(const u32x2*)(U + (rb + fr) * DM + g * 16 + 4 * fq); en[j] = (u32x2){0u, 0u}; }
    for (int grp = 0; grp < 36; ++grp) {
        u32x2 uvc[4]; u32x2 ec[4];
#pragma unroll
        for (int j = 0; j < 4; ++j) { uvc[j] = uvn[j]; ec[j] = en[j];
            asm volatile("" : "+v"(uvc[j]), "+v"(ec[j])); }
        if (grp + 1 < 36) {
#pragma unroll
            for (int j = 0; j < 4; ++j) { bool ic; int t1; size_t rb; chunk_rows(4 * (grp + 1) + j, d, b, ic, t1, rb);
                uvn[j] = *(const u32x2*)(U + (rb + fr) * DM + g * 16 + 4 * fq);
                en[j] = *(const u32x2*)(ESRC + (rb + fr) * DM + g * 16 + 4 * fq); (void)ic; } }
#pragma unroll
        for (int j = 0; j < 4; ++j) {
            const int ci = 4 * grp + j;
            bool is_ctx; int t0; size_t rowbase; chunk_rows(ci, d, b, is_ctx, t0, rowbase);
            const u32x2 e_c = ec[j];
            const bf16x4_t ufr = __builtin_bit_cast(bf16x4_t, uvc[j]);
            { f32x4 dacc[8];
#pragma unroll
              for (int nt = 0; nt < 8; ++nt) dacc[nt] = __builtin_amdgcn_mfma_f32_16x16x16bf16_1k(bfr[nt], ufr, (f32x4){0.f, 0.f, 0.f, 0.f}, 0, 0, 0);
              __builtin_amdgcn_sched_barrier(0);
#pragma unroll
              for (int nt = 0; nt < 8; ++nt) *(LAS f32x4*)(buL + fr * BUS + 16 * nt + 4 * fq) = dacc[nt]; }
            WAVE_SYNC();
            f32x2 bu[16];
#pragma unroll
            for (int s2 = 0; s2 < 16; ++s2) { const int tok = d ? 15 - s2 : s2; bu[s2] = *(const LAS f32x2*)(buL + tok * BUS + 2 * lane); }
            { f32x2 hv = (f32x2){hr, hi}; const f32x2 L1 = (f32x2){lr, lr}, L2 = (f32x2){-li, li};
#pragma unroll
              for (int s2 = 0; s2 < 16; ++s2) { const int tok = d ? 15 - s2 : s2;
                  const f32x2 hs = __builtin_shufflevector(hv, hv, 1, 0);
                  hv = L2 * hs + (L1 * hv + bu[s2]);
                  ((LAS unsigned*)HL)[tok * (HS / 2) + lane] = pk2(hv.x, hv.y); }
              hr = hv.x; hi = hv.y; }
            WAVE_SYNC();
            if (!is_ctx) {
                f32x4 yacc = (f32x4){0.f, 0.f, 0.f, 0.f};
#pragma unroll
                for (int ks = 0; ks < 4; ++ks) { const bf16x8 hfr = *(const LAS bf16x8*)(HL + fr * HS + 32 * ks + 8 * fq);
                    yacc = __builtin_amdgcn_mfma_f32_16x16x32_bf16(cfr[ks], hfr, yacc, 0, 0, 0); }
                if (d == 0) { yacc[0] += bf_lo(e_c.x) * s5d[0]; yacc[1] += bf_hi(e_c.x) * s5d[1]; yacc[2] += bf_lo(e_c.y) * s5d[2]; yacc[3] += bf_hi(e_c.y) * s5d[3]; }
                else { yacc[0] = gelu_tanh(yacc[0] + bf_lo(e_c.x)); yacc[1] = gelu_tanh(yacc[1] + bf_hi(e_c.x)); yacc[2] = gelu_tanh(yacc[2] + bf_lo(e_c.y)); yacc[3] = gelu_tanh(yacc[3] + bf_hi(e_c.y)); }
                u32x2 o; o.x = pk2(yacc[0], yacc[1]); o.y = pk2(yacc[2], yacc[3]);
                *(u32x2*)(PO + (rowbase + fr) * DM + g * 16 + 4 * fq) = o;
                WAVE_SYNC();
            }
        }
    }
}
__device__ __forceinline__ void s5_combine(const Args& a, int gtid, int GT) {
    const u32x4* P0 = (const u32x4*)a.out; u32x4* YG = (u32x4*)(a.ws + WS_YG); const u32x4* P1 = YG;
    for (int i = gtid; i < T * DM / 8; i += GT) { float x0[8], x1[8], o[8]; unpack8(P0[i], x0); unpack8(P1[i], x1);
#pragma unroll
        for (int e = 0; e < 8; ++e) o[e] = gelu_tanh(x0[e] + x1[e]);
        YG[i] = pack8(o); }
}

#ifdef OLD_S5
__device__ __forceinline__ void s5_item(const Args& a, LAS float* buL, LAS bf16_t* HL, int item, int lane) {
    unsigned char* ws = a.ws;
    const int b = item >> 6, g = item & 63;
    const bf16_t* U = (const bf16_t*)(ws + WS_U); bf16_t* YG = (bf16_t*)(ws + WS_YG);
    const float* LAM = (const float*)(ws + WS_LAM); const bf16_t* BBT = (const bf16_t*)(ws + WS_BBT); const bf16_t* CT = (const bf16_t*)(ws + WS_CT);
    const int fr = lane & 15, fq = lane >> 4;
    const float s5d = a.in[16][g * 16 + fr];
    for (int d = 0; d < 2; ++d) {
        const int dg = d * 64 + g;
        const float lr = LAM[2 * (dg * 64 + lane)], li = LAM[2 * (dg * 64 + lane) + 1];
        bf16x8 bfr[8], cfr[4];
#pragma unroll
        for (int nt = 0; nt < 8; ++nt) { u32x4 v = (u32x4){0u, 0u, 0u, 0u}; if (fq < 2) v = *(const u32x4*)(BBT + ((size_t)dg * 128 + 16 * nt + fr) * 16 + 8 * fq); bfr[nt] = as_bf16x8(v); }
#pragma unroll
        for (int ks = 0; ks < 4; ++ks) cfr[ks] = *(const bf16x8*)(CT + ((size_t)dg * 16 + fr) * 128 + 32 * ks + 8 * fq);
        const bf16_t* ESRC = d ? (const bf16_t*)YG : U;
        float hr = 0.f, hi = 0.f;
        u32x4 uv_n; bf16_t e_n[4];
        { bool ic; int t0; size_t rb; chunk_rows(0, d, b, ic, t0, rb);
          uv_n = *(const u32x4*)(U + (rb + fr) * DM + g * 16 + 8 * (fq & 1));
#pragma unroll
          for (int j = 0; j < 4; ++j) e_n[j] = 0; }
        for (int ci = 0; ci < 144; ++ci) {
            bool is_ctx; int t0; size_t rowbase; chunk_rows(ci, d, b, is_ctx, t0, rowbase);
            u32x4 uv = uv_n; bf16_t e_c[4];
#pragma unroll
            for (int j = 0; j < 4; ++j) e_c[j] = e_n[j];
            if (ci + 1 < 144) { bool ic; int t1; size_t rb; chunk_rows(ci + 1, d, b, ic, t1, rb);
                uv_n = *(const u32x4*)(U + (rb + fr) * DM + g * 16 + 8 * (fq & 1));
                if (!ic) {
#pragma unroll
                    for (int j = 0; j < 4; ++j) e_n[j] = ESRC[(rb + 4 * fq + j) * DM + g * 16 + fr]; } }
            if (fq >= 2) uv = (u32x4){0u, 0u, 0u, 0u};
            const bf16x8 ufr = as_bf16x8(uv);
#pragma unroll
            for (int nt = 0; nt < 8; ++nt) { f32x4 acc = (f32x4){0.f, 0.f, 0.f, 0.f};
                acc = __builtin_amdgcn_mfma_f32_16x16x32_bf16(ufr, bfr[nt], acc, 0, 0, 0);
#pragma unroll
                for (int j = 0; j < 4; ++j) buL[(4 * fq + j) * BUS + 16 * nt + fr] = acc[j]; }
            WAVE_SYNC();
            float br[16], bi[16];
#pragma unroll
            for (int s = 0; s < 16; ++s) { const int tok = d ? 15 - s : s; br[s] = buL[tok * BUS + lane]; bi[s] = buL[tok * BUS + 64 + lane]; }
#pragma unroll
            for (int s = 0; s < 16; ++s) { const int tok = d ? 15 - s : s;
                const float nr = lr * hr - li * hi + br[s], ni = lr * hi + li * hr + bi[s]; hr = nr; hi = ni;
                if (!is_ctx) { HL[tok * HS + lane] = f2bf(hr); HL[tok * HS + 64 + lane] = f2bf(hi); } }
            WAVE_SYNC();
            if (is_ctx) continue;
            f32x4 yacc = (f32x4){0.f, 0.f, 0.f, 0.f};
#pragma unroll
            for (int ks = 0; ks < 4; ++ks) { const bf16x8 afr = *(const LAS bf16x8*)(HL + fr * HS + 32 * ks + 8 * fq);
                yacc = __builtin_amdgcn_mfma_f32_16x16x32_bf16(afr, cfr[ks], yacc, 0, 0, 0); }
#pragma unroll
            for (int j = 0; j < 4; ++j) { const size_t off = (rowbase + 4 * fq + j) * DM + g * 16 + fr;
                if (d == 0) { YG[off] = f2bf(yacc[j] + bf2f(e_c[j]) * s5d); }
                else { YG[off] = f2bf(gelu_tanh(yacc[j] + bf2f(e_c[j]))); } }
            WAVE_SYNC();
        }
    }
}

#endif
__device__ __forceinline__ void wkv_readout(const Args& a, int gw, int NGW, int lane) {
    unsigned char* ws = a.ws;
    const bf16_t* rw = (const bf16_t*)(ws + WS_RW); const bf16_t* GUPT = (const bf16_t*)(ws + WS_GUPT);
    const bf16_t* Y0 = (const bf16_t*)a.out; const bf16_t* Y1 = Y0 + (size_t)T * DM;
    const float* BETA = (const float*)(ws + WS_BETA); bf16_t* RPRE = (bf16_t*)(ws + WS_RPRE);
    const float* mu = a.in[18]; const float* lng = a.in[27]; const float* lnb = a.in[28];
    const int tk = lane & 15, sg = lane >> 4;
    const bool fixed_h = (NGW & 15) == 0;
    bf16x8 wfrc[4][4];
    if (fixed_h) { const int h0 = gw & 15;
#pragma unroll
        for (int ks = 0; ks < 4; ++ks)
#pragma unroll
            for (int nt = 0; nt < 4; ++nt) { const int n = 64 * h0 + 16 * (tk >> 2) + 4 * nt + (tk & 3); wfrc[ks][nt] = *(const bf16x8*)(GUPT + (size_t)n * 128 + 32 * ks + 8 * sg); } }
    for (int item = gw; item < (T / 16) * 16; item += NGW) {
        const int tile = item >> 4, h = item & 15;
        const size_t m = (size_t)tile * 16 + tk; const int t = (int)(m & (SEQ - 1));
        f32x4 accg[4];
#pragma unroll
        for (int nt = 0; nt < 4; ++nt) accg[nt] = (f32x4){0.f, 0.f, 0.f, 0.f};
        { int dl; bool vd; nb_of(3, t, dl, vd);
#pragma unroll
          for (int ks = 0; ks < 4; ++ks) { float xg[8];
              load_lerp8(rw, m, 3200 + 32 * ks + 8 * sg, dl, vd, mu + 3200 + 32 * ks + 8 * sg, xg);
#pragma unroll
              for (int e = 0; e < 8; ++e) xg[e] = sigm(xg[e]);
              const bf16x8 gfr = as_bf16x8(pack8(xg));
#pragma unroll
              for (int nt = 0; nt < 4; ++nt) { const int n = 64 * h + 16 * (tk >> 2) + 4 * nt + (tk & 3);
                  const bf16x8 wfr = fixed_h ? wfrc[ks][nt] : *(const bf16x8*)(GUPT + (size_t)n * 128 + 32 * ks + 8 * sg);
                  accg[nt] = __builtin_amdgcn_mfma_f32_16x16x32_bf16(wfr, gfr, accg[nt], 0, 0, 0); } } }
        const int col = 64 * h + 16 * sg;
        float y0[16], y1[16], wk[16];
        { const u32x4* p0 = (const u32x4*)(Y0 + m * DM + col); const u32x4* p1 = (const u32x4*)(Y1 + m * DM + col);
          unpack8(p0[0], y0); unpack8(p0[1], y0 + 8); unpack8(p1[0], y1); unpack8(p1[1], y1 + 8); }
        float s = 0.f;
#pragma unroll
        for (int e = 0; e < 16; ++e) { wk[e] = y0[e] + y1[e]; s += wk[e]; }
        s += __shfl_xor(s, 16); s += __shfl_xor(s, 32);
        const float mean = s * (1.f / 64);
        float s2 = 0.f;
#pragma unroll
        for (int e = 0; e < 16; ++e) { wk[e] -= mean; s2 += wk[e] * wk[e]; }
        s2 += __shfl_xor(s2, 16); s2 += __shfl_xor(s2, 32);
        const float rstd = rsqrtf(s2 * (1.f / 64) + 64e-5f);
        float xv[16];
        { int dl; bool vd; nb_of(h < 7 ? 2 : 3, t, dl, vd); load_lerp16(rw, m, 2048 + col, dl, vd, mu + 2048 + col, xv); }
        const float beta = BETA[m * 16 + h] + BETA[((size_t)T + m) * 16 + h];
        float o[16];
#pragma unroll
        for (int e = 0; e < 16; ++e) { const float yn = wk[e] * rstd * lng[col + e] + lnb[col + e]; o[e] = (yn + beta * xv[e]) * accg[e >> 2][e & 3]; }
        u32x4* op = (u32x4*)(RPRE + m * DM + col);
        op[0] = pack8(o); op[1] = pack8(o + 8);
    }
}

__device__ __forceinline__ void conv_act(const Args& a, const bf16_t* ZP, bf16_t* ACT, int nrows, int gw, int NGW, int lane) {
    const float* cw = a.in[32]; const float* cb = a.in[33];
    constexpr int RUN = 16;
    const int nitems = (nrows / RUN) * 6;
    for (int item = gw; item < nitems; item += NGW) {
        const int run = item / 6, gb = item % 6;
        const int gi = gb * 64 + lane;
        if (gi >= DFF / 8) continue;
        const int pn = gi >> 4, j0 = (gi & 15) * 8;
        const int zc = 256 * pn + j0;
        const int cg_ = 128 * pn + j0;
        float wg[3][8], wv[3][8], bg[8], bv[8];
#pragma unroll
        for (int k = 0; k < 3; ++k)
#pragma unroll
            for (int e = 0; e < 8; ++e) { wg[k][e] = cw[k * 2 * DFF + cg_ + e]; wv[k][e] = cw[k * 2 * DFF + DFF + cg_ + e]; }
#pragma unroll
        for (int e = 0; e < 8; ++e) { bg[e] = cb[cg_ + e]; bv[e] = cb[DFF + cg_ + e]; }
        const int r0 = run * RUN;
        const int tseq = r0 & (SEQ - 1);
        float pg[8], pv[8], cgv[8], cvv[8], ng[8], nv[8];
        if (tseq > 0) { unpack8(*(const u32x4*)(ZP + (size_t)(r0 - 1) * (2 * DFF) + zc), pg); unpack8(*(const u32x4*)(ZP + (size_t)(r0 - 1) * (2 * DFF) + zc + 128), pv); }
        else {
#pragma unroll
            for (int e = 0; e < 8; ++e) { pg[e] = 0.f; pv[e] = 0.f; } }
        unpack8(*(const u32x4*)(ZP + (size_t)r0 * (2 * DFF) + zc), cgv); unpack8(*(const u32x4*)(ZP + (size_t)r0 * (2 * DFF) + zc + 128), cvv);
        for (int i = 0; i < RUN; ++i) {
            const int r = r0 + i;
            const bool has_next = ((r & (SEQ - 1)) != SEQ - 1);
            if (has_next) { unpack8(*(const u32x4*)(ZP + (size_t)(r + 1) * (2 * DFF) + zc), ng); unpack8(*(const u32x4*)(ZP + (size_t)(r + 1) * (2 * DFF) + zc + 128), nv); }
            else {
#pragma unroll
                for (int e = 0; e < 8; ++e) { ng[e] = 0.f; nv[e] = 0.f; } }
            float o[8];
#pragma unroll
            for (int e = 0; e < 8; ++e) { const float zg = wg[0][e] * pg[e] + wg[1][e] * cgv[e] + wg[2][e] * ng[e] + bg[e];
                const float zv = wv[0][e] * pv[e] + wv[1][e] * cvv[e] + wv[2][e] * nv[e] + bv[e];
                o[e] = zg * sigm(zg) * zv; pg[e] = cgv[e]; pv[e] = cvv[e]; cgv[e] = ng[e]; cvv[e] = nv[e]; }
            *(u32x4*)(ACT + (size_t)r * DFF + cg_) = pack8(o);
        }
    }
}
#ifndef PREP_WAVES
#define PREP_WAVES 4
#endif
#ifndef REP_P3A
#define REP_P3A 1
#endif
#ifndef REP_WKV
#define REP_WKV 1
#endif
#ifndef REP_S5
#define REP_S5 1
#endif
#ifndef REP_P2
#define REP_P2 1
#endif
__global__ void __launch_bounds__(NWAVES * 64, 2) mega_fwd(Args a) {
    extern __shared__ __attribute__((aligned(16))) unsigned char lds_raw[];
    LAS unsigned char* lds = (LAS unsigned char*)lds_raw;
    cg::grid_group grid = cg::this_grid();
    const int G = gridDim.x, NGW = G * NWAVES;
#define CG_SYNC() do { asm volatile("s_waitcnt vmcnt(0)" ::: "memory"); grid.sync(); __builtin_amdgcn_fence(__ATOMIC_ACQUIRE, "agent"); asm volatile("s_waitcnt vmcnt(0)" ::: "memory"); } while (0)
#ifdef USE_CG_SYNC
#define GRID_SYNC() CG_SYNC()
#else
#define GRID_SYNC() xcd_barrier(xbar)
#endif
#define PHASE_IDS() int tid_ = threadIdx.x; asm volatile("" : "+v"(tid_)); const int tid = tid_, lane = tid & 63, wave = __builtin_amdgcn_readfirstlane(tid >> 6), gw = blockIdx.x * NWAVES + wave; (void)gw; (void)lane
    unsigned char* ws = a.ws;
    const float* x = a.in[0]; const float* ctx = a.in[2];
    float* mod = (float*)(ws + WS_MOD);
    bf16_t* HB = (bf16_t*)(ws + WS_HB); bf16_t* U = (bf16_t*)(ws + WS_U); bf16_t* RW = (bf16_t*)(ws + WS_RW); bf16_t* YG = (bf16_t*)(ws + WS_YG);
    bf16_t* GA = (bf16_t*)(ws + WS_GA); bf16_t* GB = (bf16_t*)(ws + WS_GB); bf16_t* RPRE = (bf16_t*)(ws + WS_RPRE); bf16_t* MERGED = (bf16_t*)(ws + WS_MERGED);
    bf16_t* ZPRE = (bf16_t*)(ws + WS_ZPRE); bf16_t* ACT = (bf16_t*)(ws + WS_ACT);

    volatile LAS unsigned* xst = (volatile LAS unsigned*)(lds + LDS_BYTES - 64);
    if (threadIdx.x < 2) xst[threadIdx.x] = 0u;
    __syncthreads();
    const XcdBarrier xbar = xcd_barrier_post((unsigned*)(ws + WS_BAR), xst);
    { PHASE_IDS(); phase_prep(a, lds, G, tid, wave, lane); }
    if (a.ws == nullptr) CG_SYNC();
    GRID_SYNC();
#ifdef EXTRA_SYNCS
    for (int es = 0; es < EXTRA_SYNCS; ++es) GRID_SYNC();
#endif
    { PHASE_IDS(); norm_mod_rows(x, ctx, TA, mod, 0, 1024, a.in[6], HB, gw, NGW, lane); }
    GRID_SYNC();
    for (int rep = 0; rep < REP_P2; ++rep) {
    { pg8::Gemm g{HB, (const bf16_t*)(ws + WS_WIN_A), TA, 4352, 1024}; pg8::StaticOrder S; S.init(TA, 4352, G, (int)blockIdx.x);
      EpiSplitUR E{U, RW}; pg8::gemm_phase(lds, g, S, E); }
    GRID_SYNC();
    }
#if !defined(S5_IN_P3A)
    { PHASE_IDS();
      LAS float* buL = (LAS float*)(lds + wave * P3_S5_BYTES); LAS bf16_t* HL = (LAS bf16_t*)(lds + wave * P3_S5_BYTES + 8448);
      const int vb5 = (G == 256) ? (((int)blockIdx.x & 7) * 32 + ((int)blockIdx.x >> 3)) : (int)blockIdx.x;
      if (wave < 4) for (int r2 = 0; r2 < REP_S5; ++r2) for (int item = vb5 * 4 + wave; item < 1024; item += 4 * G) { s5_chain(a, buL, HL, 2 * item, lane); asm volatile("s_waitcnt vmcnt(0)" ::: "memory"); s5_chain(a, buL, HL, 2 * item + 1, lane); }
    }
    GRID_SYNC();
#endif
    for (int rep = 0; rep < REP_P3A; ++rep) {
#ifndef SKIP_P3A
    { PHASE_IDS();
        volatile LAS unsigned* flg = (volatile LAS unsigned*)(lds + P3_FLG);
        if (tid < 16) flg[tid] = 0u;
        if (tid >= 64 && tid < 128) ((LAS unsigned*)(lds + P3_ZERO))[tid - 64] = 0u;
        __syncthreads();
        const int bh = (G == 256) ? ((2 * ((int)blockIdx.x & 7) + (((int)blockIdx.x >> 3) >> 4)) * 16 + (((int)blockIdx.x >> 3) & 15)) : (int)blockIdx.x;
        if (wave < 4) {
#ifdef SCAN_PRIO
            __builtin_amdgcn_s_setprio(3);
#endif
            const int c = wave >> 1, hw = wave & 1;
            LAS float* ring = (LAS float*)(lds + P3_RING) + c * NSLOT * SLOT_F; LAS float* yb = (LAS float*)(lds + P3_YB + wave * 16 * YS * 4);
            unsigned seq0 = 0u;
            for (int chain = bh * 2 + c; chain < 512; chain += 2 * G, seq0 += 144u) wkv_scan_wave(a, ring, yb, (const LAS float*)(lds + P3_ZERO), flg + 4 * c, flg + 4 * c + 1 + hw, chain, hw, seq0, lane);
#ifdef SCAN_PRIO
            __builtin_amdgcn_s_setprio(0);
#endif
        } else if (PREP_WAVES == 2 && wave >= 6) {
#ifdef S5_IN_P3A
            const int i = wave - 6;
            LAS float* buL = (LAS float*)(lds + P3_END + i * P3_S5_BYTES); LAS bf16_t* HL = (LAS bf16_t*)(lds + P3_END + i * P3_S5_BYTES + 8448);
            for (int base = blockIdx.x * 4; base < 1024; base += 4 * G)
                for (int j = 0; j < 2; ++j) { const int item = base + 2 * i + j; s5_chain(a, buL, HL, 2 * item, lane); asm volatile("s_waitcnt vmcnt(0)" ::: "memory"); s5_chain(a, buL, HL, 2 * item + 1, lane); }
#endif
        } else if (PREP_WAVES == 4 || wave < 6) {
#ifdef PREP_PRIO
            __builtin_amdgcn_s_setprio(3);
#endif
            const int c = (PREP_WAVES == 4) ? ((wave - 4) >> 1) : (wave - 4), parity = (PREP_WAVES == 4) ? ((wave - 4) & 1) : 0;
            LAS float* ring = (LAS float*)(lds + P3_RING) + c * NSLOT * SLOT_F; LAS float* cst = (LAS float*)(lds + P3_CST + (wave - 4) * 2560);
            unsigned seq0 = 0u;
            for (int chain = bh * 2 + c; chain < 512; chain += 2 * G, seq0 += 144u) wkv_prep_wave(a, ring, cst, flg + 4 * c, flg + 4 * c + 1, flg + 4 * c + 2, chain, seq0, parity, (PREP_WAVES == 4) ? 2 : 1, lane);
        }
    }
#endif
    GRID_SYNC();
    }
    { PHASE_IDS(); wkv_readout(a, gw, NGW, lane); }
    GRID_SYNC();
    { pg8::Gemm g{YG, (const bf16_t*)(ws + WS_WGLU), T, 2048, 1024}; pg8::StaticOrder S; S.init(T, 2048, G, (int)blockIdx.x);
      EpiGlu E{GA}; pg8::gemm_phase(lds, g, S, E); }
    { pg8::Gemm g{RPRE, (const bf16_t*)(ws + WS_WROUT), T, 1024, 1024}; pg8::StaticOrder S; S.init(T, 1024, G, (int)blockIdx.x);
      EpiPlainBf16 E{GB, 1024}; pg8::gemm_phase(lds, g, S, E); }
    GRID_SYNC();
    { pg8::Gemm g{HB, (const bf16_t*)(ws + WS_WIN_G), T, 2048, 1024}; pg8::StaticOrder S; S.init(T, 2048, G, (int)blockIdx.x);
      EpiMerge E{GA, GB, MERGED}; pg8::gemm_phase(lds, g, S, E); }
    GRID_SYNC();
    { pg8::Gemm g{MERGED, (const bf16_t*)(ws + WS_WOUT), T, 1024, 1024}; pg8::StaticOrder S; S.init(T, 1024, G, (int)blockIdx.x);
      EpiRes E{x, a.out, mod + 2048}; pg8::gemm_phase(lds, g, S, E); }
    GRID_SYNC();
    { PHASE_IDS(); norm_mod_rows(a.out, nullptr, T, mod, 3072, 4096, a.in[7], HB, gw, NGW, lane); }
    GRID_SYNC();
    for (int half = 0; half < 2; ++half) {
        { pg8::Gemm g{HB + (size_t)half * (T / 2) * DM, (const bf16_t*)(ws + WS_WUP), T / 2, 2 * DFF, 1024}; pg8::StaticOrder S; S.init(T / 2, 2 * DFF, G, (int)blockIdx.x);
          EpiPlainBf16 E{ZPRE, 2 * DFF}; pg8::gemm_phase(lds, g, S, E); }
        GRID_SYNC();
        { PHASE_IDS(); conv_act(a, ZPRE, ACT + (size_t)half * (T / 2) * DFF, T / 2, gw, NGW, lane); }
        GRID_SYNC();
    }
    { pg8::Gemm g{ACT, (const bf16_t*)(ws + WS_WDOWN), T, 1024, DFF}; pg8::StaticOrder S; S.init(T, 1024, G, (int)blockIdx.x);
      EpiRes E{a.out, a.out, mod + 5120}; pg8::gemm_phase(lds, g, S, E); }
    GRID_SYNC();
    { PHASE_IDS(); final_norm_rows(a.out, a.in[35], gw, NGW, lane); }
}

extern "C" void kernel_launch(void* const* d_in, const int* in_sizes, int n_in, void* d_out, int out_size, void* d_ws, size_t ws_size, hipStream_t stream) {
    static int grid = 0;
    if (grid == 0) {
        if (n_in != 36 || out_size != T * DM || ws_size < WS_END) { fprintf(stderr, "kernel_launch: unexpected shapes: n_in %d out %d ws %zu (need %zu)\n", n_in, out_size, ws_size, (size_t)WS_END); grid = -1; return; }
        int dev = 0, cus = 0, per_cu = 0;
        if (hipGetDevice(&dev) != hipSuccess || hipDeviceGetAttribute(&cus, hipDeviceAttributeMultiprocessorCount, dev) != hipSuccess) { grid = -1; return; }
        if (hipFuncSetAttribute((const void*)mega_fwd, hipFuncAttributeMaxDynamicSharedMemorySize, LDS_BYTES) != hipSuccess) { fprintf(stderr, "kernel_launch: hipFuncSetAttribute failed\n"); grid = -1; return; }
        if (hipOccupancyMaxActiveBlocksPerMultiprocessor(&per_cu, (const void*)mega_fwd, NWAVES * 64, LDS_BYTES) != hipSuccess || per_cu < 1) per_cu = 1;
        (void)hipGetLastError();
        grid = cus * per_cu;
        fprintf(stderr, "kernel_launch: grid %d (cus %d x %d), ws %zu\n", grid, cus, per_cu, ws_size);
    }
    if (grid < 0) return;
    if (hipMemsetAsync((char*)d_ws + WS_BAR, 0, 16384, stream) != hipSuccess) { fprintf(stderr, "kernel_launch: hipMemsetAsync failed\n"); return; }
    Args a{};
    for (int i = 0; i < 36; ++i) a.in[i] = (const float*)d_in[i];
    a.out = (float*)d_out; a.ws = (unsigned char*)d_ws;
    void* args[] = {&a};
    hipError_t e = hipLaunchCooperativeKernel((const void*)mega_fwd, dim3(grid), dim3(NWAVES * 64), args, LDS_BYTES, stream);
    if (e != hipSuccess) fprintf(stderr, "kernel_launch: cooperative launch failed: %s (grid %d)\n", hipGetErrorString(e), grid);
}
```

```cpp
#include <hip/hip_runtime.h>
#include <hip/hip_cooperative_groups.h>
#include <cstdio>
#include <cstdint>
namespace cg = cooperative_groups;

namespace pg8 {
#define PG8_LAS __attribute__((address_space(3)))
typedef unsigned short bf16_t;
typedef short bf16x8 __attribute__((ext_vector_type(8)));
typedef float f32x4 __attribute__((ext_vector_type(4)));
typedef unsigned u32x4 __attribute__((ext_vector_type(4)));
constexpr int BM = 256, BK = 64, HALF = 128, HTB = HALF * BK * 2, STAGE_BYTES = 8 * HTB, NXCD = 8, WGM = 4;

__host__ __device__ __forceinline__ int lds_byte(int r, int c) { const int st = (r >> 4) * 2 + (c >> 5), rr = r & 15, cc = c & 31, ob = rr * 64 + cc * 2; return st * 1024 + (ob ^ (((ob >> 9) & 1) << 5)); }
__host__ __device__ __forceinline__ void stage_rc(int b, int& R, int& C) { const int st = b / 1024, sb = b % 1024, swz = sb ^ (((sb >> 9) & 1) << 5); R = (st >> 1) * 16 + swz / 64; C = (st & 1) * 32 + (swz % 64) / 2; }
__host__ __device__ __forceinline__ int perm32(int rho) { const int n = rho >> 4, i = rho & 15; return 8 * (i >> 2) + 4 * n + (i & 3); }

struct Unit { int pm, pn; };
struct Gemm { const bf16_t* A; const bf16_t* Bt; int M, N, K; };

struct StaticOrder {
    int nM, nN, nwg, G, c;
    __host__ __device__ void init(int M, int N, int G_, int c_) { nM = M / BM; nN = N / BM; nwg = nM * nN; G = G_; c = c_; }
    __host__ __device__ bool next(int i, Unit& u) const {
        const long L = (long)i * G + c; if (L >= nwg) return false;
        int wgid = (int)L; { const int q = nwg / NXCD, r = nwg % NXCD, xcd = wgid % NXCD, off = wgid / NXCD; wgid = (xcd < r ? xcd * (q + 1) : r * (q + 1) + (xcd - r) * q) + off; }
        const int nig = WGM * nN, gid = wgid / nig, fm = gid * WGM, gsz = (nM - fm) < WGM ? (nM - fm) : WGM;
        u.pm = fm + ((wgid % nig) % gsz); u.pn = (wgid % nig) / gsz; return true;
    }
};

typedef float f32x2_cv __attribute__((ext_vector_type(2)));
typedef __bf16 bf16x2_cv __attribute__((ext_vector_type(2)));
__device__ __forceinline__ unsigned cvt_pk_bf16(float lo, float hi) { const bf16x2_cv v = __builtin_convertvector((f32x2_cv){lo, hi}, bf16x2_cv); return __builtin_bit_cast(unsigned, v); }

template <class Epi>
__device__ __forceinline__ void gemm_phase(PG8_LAS unsigned char* lds, const Gemm g, const StaticOrder& S, const Epi& E) {
    int tid_ = threadIdx.x; asm volatile("" : "+v"(tid_));
    const int tid = tid_, wid = __builtin_amdgcn_readfirstlane(tid >> 6), lane = tid & 63, wr = wid >> 2, wc = wid & 3, fr = lane & 15, fq = lane >> 4;
    const int K = g.K, nt = K / BK;
    unsigned voffA[2], voffB[2];
#pragma unroll
    for (int i = 0; i < 2; ++i) { int R, C; stage_rc(tid * 16 + i * 8192, R, C); const int Rb = Epi::PERM ? ((R & ~31) + perm32(R & 31)) : R;
        voffA[i] = (unsigned)(R * K + C) * 2u; voffB[i] = (unsigned)(Rb * K + C) * 2u; }
    const size_t kstep = (size_t)(BK * 2);
    const size_t hstep = (size_t)HALF * K * 2;
    const size_t tstep = 2 * hstep;
    const unsigned ldsw = (unsigned)wid * 1024u;
    const int aoff = lds_byte(wr * 64 + fr, fq * 8), boff = lds_byte(wc * 32 + fr, fq * 8);
#define PG8_SA(b, h) (((b) * 2 + (h)) * HTB)
#define PG8_SB(b, h) ((4 + (b) * 2 + (h)) * HTB)
#define PG8_STAGE(bufoff, gbase, voff) do { _Pragma("unroll") for (int _i = 0; _i < 2; ++_i) \
        __builtin_amdgcn_global_load_lds((const unsigned*)((const char*)(gbase) + (voff)[_i]), (PG8_LAS unsigned*)(lds + (bufoff) + ldsw + _i * 8192), 16, 0, 0); } while (0)
#define PG8_LDA(dst, b, h) do { _Pragma("unroll") for (int m = 0; m < 4; ++m) _Pragma("unroll") for (int k = 0; k < 2; ++k) dst[m][k] = *(const PG8_LAS bf16x8*)(lds + PG8_SA(b, h) + aoff + m * 2048 + k * 1024); } while (0)
#define PG8_LDB(dst, b, h) do { _Pragma("unroll") for (int n = 0; n < 2; ++n) _Pragma("unroll") for (int k = 0; k < 2; ++k) dst[n][k] = *(const PG8_LAS bf16x8*)(lds + PG8_SB(b, h) + boff + n * 2048 + k * 1024); } while (0)
#define PG8_MMA(ai, bj, At, Bt) do { __builtin_amdgcn_s_setprio(1); _Pragma("unroll") for (int m = 0; m < 4; ++m) _Pragma("unroll") for (int n = 0; n < 2; ++n) _Pragma("unroll") for (int k = 0; k < 2; ++k) \
        acc[ai][bj][m][n] = __builtin_amdgcn_mfma_f32_16x16x32_bf16(Bt[n][k], At[m][k], acc[ai][bj][m][n], 0, 0, 0); __builtin_amdgcn_s_setprio(0); } while (0)
#define PG8_WAIT_V(n) asm volatile("s_waitcnt vmcnt(" #n ")" ::: "memory")
#define PG8_WAIT_L(n) asm volatile("s_waitcnt lgkmcnt(" #n ")" ::: "memory")
#define PG8_BAR __builtin_amdgcn_s_barrier()
#define PG8_SCHED __builtin_amdgcn_sched_barrier(0)
    Unit cur, nxt; int ui = 0;
    if (!S.next(0, cur)) return;
    f32x4 acc[2][2][4][2];
#pragma unroll
    for (int a = 0; a < 2; ++a)
#pragma unroll
        for (int b = 0; b < 2; ++b)
#pragma unroll
            for (int m = 0; m < 4; ++m)
#pragma unroll
                for (int n = 0; n < 2; ++n) acc[a][b][m][n] = (f32x4){0.f, 0.f, 0.f, 0.f};
    bf16x8 At[4][2], B0[2][2], B1[2][2];
    const char* cA = (const char*)g.A + (size_t)cur.pm * tstep; const char* cB = (const char*)g.Bt + (size_t)cur.pn * tstep;
    PG8_STAGE(PG8_SB(0, 0), cB, voffB); PG8_STAGE(PG8_SA(0, 0), cA, voffA); PG8_STAGE(PG8_SB(0, 1), cB + hstep, voffB); PG8_STAGE(PG8_SA(0, 1), cA + hstep, voffA);
    if (wr == 1) PG8_BAR;
    PG8_WAIT_V(4); PG8_BAR;
    PG8_STAGE(PG8_SB(1, 0), cB + kstep, voffB); PG8_STAGE(PG8_SA(1, 0), cA + kstep, voffA); PG8_STAGE(PG8_SB(1, 1), cB + hstep + kstep, voffB);
    PG8_WAIT_V(6); PG8_BAR;
    for (;;) {
        const bool has_next = S.next(ui + 1, nxt);
        const char* nA = has_next ? (const char*)g.A + (size_t)nxt.pm * tstep : cA; const char* nB = has_next ? (const char*)g.Bt + (size_t)nxt.pn * tstep : cB;
        for (int t = 0; t < nt; t += 2) {
            const bool last = (t == nt - 2);
            const char* a1 = cA + (size_t)(t + 1) * kstep;
            const char* a2 = last ? nA : cA + (size_t)(t + 2) * kstep; const char* b2 = last ? nB : cB + (size_t)(t + 2) * kstep;
            const char* a3 = a2 + kstep; const char* b3 = b2 + kstep;
            PG8_LDB(B0, 0, 0); PG8_SCHED; PG8_LDA(At, 0, 0); PG8_STAGE(PG8_SA(1, 1), a1 + hstep, voffA);
            PG8_WAIT_L(8); PG8_BAR; PG8_WAIT_L(0); PG8_MMA(0, 0, At, B0); PG8_BAR; PG8_SCHED;
            PG8_LDB(B1, 0, 1); PG8_STAGE(PG8_SB(0, 0), b2, voffB);
            PG8_BAR; PG8_WAIT_L(0); PG8_MMA(0, 1, At, B1); PG8_BAR;
            PG8_LDA(At, 0, 1); PG8_STAGE(PG8_SA(0, 0), a2, voffA);
            PG8_BAR; PG8_WAIT_L(0); PG8_MMA(1, 0, At, B0); PG8_BAR; PG8_SCHED;
            PG8_STAGE(PG8_SB(0, 1), b2 + hstep, voffB);
            PG8_WAIT_V(6); PG8_BAR; PG8_MMA(1, 1, At, B1); PG8_BAR;
            PG8_LDB(B0, 1, 0); PG8_SCHED; PG8_LDA(At, 1, 0); PG8_STAGE(PG8_SA(0, 1), a2 + hstep, voffA);
            PG8_WAIT_L(8); PG8_BAR; PG8_WAIT_L(0); PG8_MMA(0, 0, At, B0); PG8_BAR; PG8_SCHED;
            PG8_LDB(B1, 1, 1); PG8_STAGE(PG8_SB(1, 0), b3, voffB);
            PG8_BAR; PG8_WAIT_L(0); PG8_MMA(0, 1, At, B1); PG8_BAR;
            PG8_LDA(At, 1, 1); PG8_STAGE(PG8_SA(1, 0), a3, voffA);
            PG8_BAR; PG8_WAIT_L(0); PG8_MMA(1, 0, At, B0); PG8_BAR; PG8_SCHED;
            PG8_STAGE(PG8_SB(1, 1), b3 + hstep, voffB);
            PG8_WAIT_V(6); PG8_BAR; PG8_MMA(1, 1, At, B1); PG8_BAR;
        }
        E(acc, cur, wr, wc, fr, fq);
        if (!has_next) break;
#pragma unroll
        for (int a = 0; a < 2; ++a)
#pragma unroll
            for (int b = 0; b < 2; ++b)
#pragma unroll
                for (int m = 0; m < 4; ++m)
#pragma unroll
                    for (int n = 0; n < 2; ++n) acc[a][b][m][n] = (f32x4){0.f, 0.f, 0.f, 0.f};
        cur = nxt; cA = nA; cB = nB; ++ui;
    }
    PG8_WAIT_V(0);
    if (wr == 0) PG8_BAR;
    PG8_BAR;
#undef PG8_SA
#undef PG8_SB
#undef PG8_STAGE
#undef PG8_LDA
#undef PG8_LDB
#undef PG8_MMA
#undef PG8_WAIT_V
#undef PG8_WAIT_L
#undef PG8_BAR
#undef PG8_SCHED
}
}
#define LAS __attribute__((address_space(3)))
typedef unsigned short bf16_t;
typedef short bf16x8 __attribute__((ext_vector_type(8)));
typedef float f32x4 __attribute__((ext_vector_type(4)));
typedef float f32x2 __attribute__((ext_vector_type(2)));
typedef unsigned u32x4 __attribute__((ext_vector_type(4)));
typedef unsigned u32x2 __attribute__((ext_vector_type(2)));

constexpr int NB = 16, SEQ = 2048, DM = 1024, CTXL = 256;
constexpr int T = NB * SEQ, TC = NB * CTXL, TA = T + TC;
constexpr int RWC = 3328, DFF = 2816, NMOD = 6144;
constexpr int NWAVES = 8;
constexpr int LDS_BYTES = 155648;

constexpr size_t MiB = 1u << 20;
constexpr size_t WS_WIN_A = 0, WS_WIN_G = 9 * MiB, WS_WGLU = 13 * MiB, WS_WROUT = 17 * MiB, WS_WOUT = 19 * MiB, WS_WUP = 21 * MiB, WS_WDOWN = 32 * MiB;
constexpr size_t WS_WUPT = 38 * MiB, WS_AUPT = WS_WUPT + 256 * 1024, WS_GUPT = WS_AUPT + 256 * 1024;
constexpr size_t WS_MOD = 39 * MiB, WS_LAM = 40 * MiB, WS_BBT = 40 * MiB + 512 * 1024, WS_CT = 41 * MiB + 512 * 1024, WS_BETA = 43 * MiB;
constexpr size_t WS_BAR = 47 * MiB;
constexpr size_t WS_HB = 48 * MiB, WS_U = 120 * MiB, WS_RW = 192 * MiB, WS_YG = 426 * MiB;
constexpr size_t WS_GA = 192 * MiB, WS_GB = 256 * MiB, WS_RPRE = 120 * MiB, WS_MERGED = 120 * MiB;
constexpr size_t WS_ZPRE = 112 * MiB, WS_ACT = 288 * MiB, WS_END = 512 * MiB;

struct Args { const float* in[36]; float* out; unsigned char* ws; };

__device__ __forceinline__ float bf_lo(unsigned w) { return __uint_as_float(w << 16); }
__device__ __forceinline__ float bf_hi(unsigned w) { return __uint_as_float(w & 0xffff0000u); }
__device__ __forceinline__ float bf2f(bf16_t h) { return __uint_as_float(((unsigned)h) << 16); }
__device__ __forceinline__ unsigned pk2(float a, float b) { return pg8::cvt_pk_bf16(a, b); }
__device__ __forceinline__ bf16_t f2bf(float f) { return (bf16_t)(pk2(f, 0.f) & 0xffffu); }
__device__ __forceinline__ float sigm(float x) { return __builtin_amdgcn_rcpf(1.f + __expf(-x)); }
__device__ __forceinline__ float tanh_(float x) { return 1.f - 2.f * __builtin_amdgcn_rcpf(__expf(2.f * x) + 1.f); }
__device__ __forceinline__ float gelu_tanh(float x) { const float z = 1.5957691216057308f * (x + 0.044715f * x * x * x); return x * sigm(z); }
__device__ __forceinline__ float wave_sum(float v) {
#pragma unroll
    for (int o = 1; o < 64; o <<= 1) v += __shfl_xor(v, o);
    return v;
}
__device__ __forceinline__ void unpack8(const u32x4 w, float* o) { o[0] = bf_lo(w.x); o[1] = bf_hi(w.x); o[2] = bf_lo(w.y); o[3] = bf_hi(w.y); o[4] = bf_lo(w.z); o[5] = bf_hi(w.z); o[6] = bf_lo(w.w); o[7] = bf_hi(w.w); }
__device__ __forceinline__ u32x4 pack8(const float* v) { u32x4 o; o.x = pk2(v[0], v[1]); o.y = pk2(v[2], v[3]); o.z = pk2(v[4], v[5]); o.w = pk2(v[6], v[7]); return o; }
__device__ __forceinline__ bf16x8 as_bf16x8(u32x4 v) { return __builtin_bit_cast(bf16x8, v); }
#define LDS_WAIT() asm volatile("s_waitcnt lgkmcnt(0)" ::: "memory")
#define WAVE_SYNC() do { asm volatile("s_waitcnt lgkmcnt(0)" ::: "memory"); __builtin_amdgcn_wave_barrier(); } while (0)
template <int CTRL> __device__ __forceinline__ float dpp_f(float v) { return __builtin_bit_cast(float, __builtin_amdgcn_update_dpp(0, __builtin_bit_cast(int, v), CTRL, 0xF, 0xF, true)); }
__device__ __forceinline__ float red8(float v) { v += dpp_f<0xB1>(v); v += dpp_f<0x4E>(v); v += dpp_f<0x141>(v); return v; }

using pg8::Unit;
struct EpiSplitUR {
    static constexpr bool PERM = true;
    bf16_t* U; bf16_t* RW;
    __device__ __forceinline__ void operator()(const f32x4 (&acc)[2][2][4][2], const Unit& u, int wr, int wc, int fr, int fq) const {
        int colt = u.pn * 256; bf16_t* base; int ldc;
        if (colt < 1024) { base = U; ldc = 1024; } else { base = RW; ldc = RWC; colt -= 1024; }
        const int row0 = u.pm * 256 + wr * 64 + fr, col0 = colt + wc * 32 + 8 * fq;
#pragma unroll
        for (int ai = 0; ai < 2; ++ai)
#pragma unroll
            for (int m = 0; m < 4; ++m) { bf16_t* rowp = base + (size_t)(row0 + ai * 128 + m * 16) * ldc + col0;
#pragma unroll
                for (int bj = 0; bj < 2; ++bj) { const f32x4 v0 = acc[ai][bj][m][0], v1 = acc[ai][bj][m][1];
                    u32x4 w; w.x = pk2(v0[0], v0[1]); w.y = pk2(v0[2], v0[3]); w.z = pk2(v1[0], v1[1]); w.w = pk2(v1[2], v1[3]);
                    *(u32x4*)(rowp + bj * 128) = w; } }
    }
};
struct EpiPlainBf16 {
    static constexpr bool PERM = true;
    bf16_t* O; int ldc;
    __device__ __forceinline__ void operator()(const f32x4 (&acc)[2][2][4][2], const Unit& u, int wr, int wc, int fr, int fq) const {
        const int row0 = u.pm * 256 + wr * 64 + fr, col0 = u.pn * 256 + wc * 32 + 8 * fq;
#pragma unroll
        for (int ai = 0; ai < 2; ++ai)
#pragma unroll
            for (int m = 0; m < 4; ++m) { bf16_t* rowp = O + (size_t)(row0 + ai * 128 + m * 16) * ldc + col0;
#pragma unroll
                for (int bj = 0; bj < 2; ++bj) { const f32x4 v0 = acc[ai][bj][m][0], v1 = acc[ai][bj][m][1];
                    u32x4 w; w.x = pk2(v0[0], v0[1]); w.y = pk2(v0[2], v0[3]); w.z = pk2(v1[0], v1[1]); w.w = pk2(v1[2], v1[3]);
                    *(u32x4*)(rowp + bj * 128) = w; } }
    }
};
struct EpiGlu {
    static constexpr bool PERM = true;
    bf16_t* O;
    __device__ __forceinline__ void operator()(const f32x4 (&acc)[2][2][4][2], const Unit& u, int wr, int wc, int fr, int fq) const {
        const int row0 = u.pm * 256 + wr * 64 + fr, col0 = u.pn * 128 + wc * 32 + 8 * fq;
#pragma unroll
        for (int ai = 0; ai < 2; ++ai)
#pragma unroll
            for (int m = 0; m < 4; ++m) { bf16_t* rowp = O + (size_t)(row0 + ai * 128 + m * 16) * DM + col0;
                float o[8];
#pragma unroll
                for (int n = 0; n < 2; ++n)
#pragma unroll
                    for (int e = 0; e < 4; ++e) o[4 * n + e] = acc[ai][0][m][n][e] * sigm(acc[ai][1][m][n][e]);
                *(u32x4*)rowp = pack8(o); }
    }
};
struct EpiMerge {
    static constexpr bool PERM = true;
    const bf16_t* A; const bf16_t* B; bf16_t* O;
    __device__ __forceinline__ void operator()(const f32x4 (&acc)[2][2][4][2], const Unit& u, int wr, int wc, int fr, int fq) const {
        const int row0 = u.pm * 256 + wr * 64 + fr, col0 = u.pn * 128 + wc * 32 + 8 * fq;
#pragma unroll
        for (int ai = 0; ai < 2; ++ai)
#pragma unroll
            for (int m = 0; m < 4; ++m) { const size_t off = (size_t)(row0 + ai * 128 + m * 16) * DM + col0;
                float av[8], bv[8], o[8];
                unpack8(*(const u32x4*)(A + off), av); unpack8(*(const u32x4*)(B + off), bv);
#pragma unroll
                for (int n = 0; n < 2; ++n)
#pragma unroll
                    for (int e = 0; e < 4; ++e) o[4 * n + e] = sigm(acc[ai][0][m][n][e]) * av[4 * n + e] + sigm(acc[ai][1][m][n][e]) * bv[4 * n + e];
                *(u32x4*)(O + off) = pack8(o); }
    }
};
struct EpiRes {
    static constexpr bool PERM = false;
    const float* X; float* O; const float* gate;
    __device__ __forceinline__ void operator()(const f32x4 (&acc)[2][2][4][2], const Unit& u, int wr, int wc, int fr, int fq) const {
        const int row0 = u.pm * 256 + wr * 64 + fr, col0 = u.pn * 256 + wc * 32 + 4 * fq;
#pragma unroll
        for (int ai = 0; ai < 2; ++ai)
#pragma unroll
            for (int m = 0; m < 4; ++m) { const int row = row0 + ai * 128 + m * 16; const float* gp = gate + (size_t)(row >> 11) * NMOD + col0;
                const float* xp = X + (size_t)row * DM + col0; float* op = O + (size_t)row * DM + col0;
#pragma unroll
                for (int bj = 0; bj < 2; ++bj)
#pragma unroll
                    for (int n = 0; n < 2; ++n) { const int c = bj * 128 + n * 16; const f32x4 g4 = *(const f32x4*)(gp + c), x4 = *(const f32x4*)(xp + c);
                        *(f32x4*)(op + c) = x4 + g4 * acc[ai][bj][m][n]; } }
    }
};

__device__ __forceinline__ void transpose_item(const float* W, int N, bf16_t* WT, int K, int k0, int src_col0, int dst_row0, LAS float* scr, int lane) {
#pragma unroll 8
    for (int i = 0; i < 32; ++i) { const int kk = 2 * i + (lane >> 5); scr[kk * 33 + (lane & 31)] = W[(size_t)(k0 + kk) * N + src_col0 + (lane & 31)]; }
    WAVE_SYNC();
    const int c = lane & 7;
#pragma unroll
    for (int j = 0; j < 4; ++j) { const int n = (lane >> 3) + 8 * j; const LAS float* s = scr + (8 * c) * 33 + n;
        u32x4 o; o.x = pk2(s[0 * 33], s[1 * 33]); o.y = pk2(s[2 * 33], s[3 * 33]); o.z = pk2(s[4 * 33], s[5 * 33]); o.w = pk2(s[6 * 33], s[7 * 33]);
        *(u32x4*)(WT + (size_t)(dst_row0 + n) * K + k0 + 8 * c) = o; }
    WAVE_SYNC();
}
__device__ __forceinline__ void sincos_d(double x, double& s, double& c) {
    const double k = rint(x * 0.6366197723675814);
    double r = fma(-k, 1.5707963267948966, x); r = fma(-k, 6.123233995736766e-17, r);
    const int q = ((int)k) & 3;
    const double r2 = r * r;
    const double sp = r * (1.0 + r2 * (-1.0 / 6 + r2 * (1.0 / 120 + r2 * (-1.0 / 5040 + r2 * (1.0 / 362880 + r2 * (-1.0 / 39916800 + r2 * (1.0 / 6227020800.0)))))));
    const double cp = 1.0 + r2 * (-0.5 + r2 * (1.0 / 24 + r2 * (-1.0 / 720 + r2 * (1.0 / 40320 + r2 * (-1.0 / 3628800 + r2 * (1.0 / 479001600.0 + r2 * (-1.0 / 87178291200.0)))))));
    s = (q == 0) ? sp : (q == 1) ? cp : (q == 2) ? -sp : -cp;
    c = (q == 0) ? cp : (q == 1) ? -sp : (q == 2) ? -cp : sp;
}
__device__ __forceinline__ double exp_small_d(double x) {
    return 1.0 + x * (1.0 + x * (0.5 + x * (1.0 / 6 + x * (1.0 / 24 + x * (1.0 / 120 + x * (1.0 / 720 + x * (1.0 / 5040 + x * (1.0 / 40320 + x * (1.0 / 362880)))))))));
}

__device__ __forceinline__ void phase_prep(const Args& a, LAS unsigned char* lds, int G, int tid, int wave, int lane) {
    unsigned char* ws = a.ws;
    {
        const float* c = a.in[1]; const float* cctx = a.in[3]; const float* wmod = a.in[4]; const float* bmod = a.in[5];
        float* mod = (float*)(ws + WS_MOD);
        for (int item = blockIdx.x; item < NMOD / 64; item += G) {
            const int j0 = item * 64, kb = wave * 128;
            LAS float* cs = (LAS float*)(lds + wave * 9216);
            for (int i = lane; i < 17 * 128; i += 64) { const int b = i >> 7, k = i & 127; const float v = (b < 16) ? c[b * DM + kb + k] : cctx[kb + k]; cs[i] = v * sigm(v); }
            WAVE_SYNC();
            float acc[17];
#pragma unroll
            for (int b = 0; b < 17; ++b) acc[b] = 0.f;
            for (int k4 = 0; k4 < 32; ++k4) {
                const float* wp = wmod + (size_t)(kb + 4 * k4) * NMOD + j0 + lane;
                const float w0 = wp[0], w1 = wp[NMOD], w2 = wp[2 * NMOD], w3 = wp[3 * NMOD];
#pragma unroll
                for (int b = 0; b < 17; ++b) { const f32x4 cv = *(const LAS f32x4*)(cs + b * 128 + 4 * k4); acc[b] += cv.x * w0 + cv.y * w1 + cv.z * w2 + cv.w * w3; }
            }
            LAS float* red = (LAS float*)(lds + 73728);
#pragma unroll
            for (int b = 0; b < 17; ++b) red[(wave * 17 + b) * 64 + lane] = acc[b];
            __syncthreads();
            for (int o = tid; o < 17 * 64; o += NWAVES * 64) { const int b = o >> 6, l = o & 63; float s = 0.f;
#pragma unroll
                for (int w = 0; w < 8; ++w) s += red[(w * 17 + b) * 64 + l];
                mod[(size_t)b * NMOD + j0 + l] = s + bmod[j0 + l]; }
            __syncthreads();
        }
    }
    __syncthreads();
    {
        LAS float* scr = (LAS float*)(lds + wave * 16384);
        const int nskip = 0;
        const int gw = ((int)blockIdx.x - nskip) * NWAVES + wave, NGW = (G - nskip) * NWAVES;
        constexpr int NI0 = 16 * 136, NI1 = 16 * 64, NI2 = 16 * 64, NI3 = 16 * 32, NI4 = 16 * 32, NI5 = 16 * 176, NI6 = 44 * 32, NI7 = 32, NI11 = 64;
        constexpr int NTOT = NI0 + NI1 + NI2 + NI3 + NI4 + NI5 + NI6 + 4 * NI7 + NI11;
        for (int it = (gw >= 0) ? gw : NTOT; it < NTOT; it += NGW) {
            int r = it; const float* W; bf16_t* WT; int K, Nsrc, Ndst, mode, off, half;
            if (r < NI0) { W = a.in[8]; WT = (bf16_t*)(ws + WS_WIN_A); K = 1024; Nsrc = 6400; Ndst = 4352; mode = 0; off = 0; half = 0; }
            else if ((r -= NI0) < NI1) { W = a.in[8]; WT = (bf16_t*)(ws + WS_WIN_G); K = 1024; Nsrc = 6400; Ndst = 2048; mode = 1; off = 4352; half = 1024; }
            else if ((r -= NI1) < NI2) { W = a.in[17]; WT = (bf16_t*)(ws + WS_WGLU); K = 1024; Nsrc = 2048; Ndst = 2048; mode = 1; off = 0; half = 1024; }
            else if ((r -= NI2) < NI3) { W = a.in[29]; WT = (bf16_t*)(ws + WS_WROUT); K = 1024; Nsrc = 1024; Ndst = 1024; mode = 0; off = 0; half = 0; }
            else if ((r -= NI3) < NI4) { W = a.in[30]; WT = (bf16_t*)(ws + WS_WOUT); K = 1024; Nsrc = 1024; Ndst = 1024; mode = 0; off = 0; half = 0; }
            else if ((r -= NI4) < NI5) { W = a.in[31]; WT = (bf16_t*)(ws + WS_WUP); K = 1024; Nsrc = 5632; Ndst = 5632; mode = 1; off = 0; half = 2816; }
            else if ((r -= NI5) < NI6) { W = a.in[34]; WT = (bf16_t*)(ws + WS_WDOWN); K = 2816; Nsrc = 1024; Ndst = 1024; mode = 0; off = 0; half = 0; }
            else if ((r -= NI6) < 2 * NI7) { const int d = r / NI7; r -= d * NI7; W = a.in[20] + (size_t)d * 64 * 1024; WT = (bf16_t*)(ws + WS_WUPT) + (size_t)d * 1024 * 64; K = 64; Nsrc = 1024; Ndst = 1024; mode = 0; off = 0; half = 0; }
            else if ((r -= 2 * NI7) < 2 * NI7) { const int d = r / NI7; r -= d * NI7; W = a.in[22] + (size_t)d * 64 * 1024; WT = (bf16_t*)(ws + WS_AUPT) + (size_t)d * 1024 * 64; K = 64; Nsrc = 1024; Ndst = 1024; mode = 0; off = 0; half = 0; }
            else { r -= 2 * NI7; W = a.in[23]; WT = (bf16_t*)(ws + WS_GUPT); K = 128; Nsrc = 1024; Ndst = 1024; mode = 0; off = 0; half = 0; }
            const int nblk = Ndst / 32, kb = r / nblk, nb = r % nblk, dr0 = 32 * nb;
            const int sc0 = mode ? (off + ((dr0 & 255) >> 7) * half + 128 * (dr0 >> 8) + (dr0 & 127)) : (off + dr0);
            transpose_item(W, Nsrc, WT, K, 64 * kb, sc0, dr0, scr, lane);
        }
    }
    {
        float* LAM = (float*)(ws + WS_LAM); bf16_t* BBT = (bf16_t*)(ws + WS_BBT); bf16_t* CT = (bf16_t*)(ws + WS_CT);
        const float* are = a.in[9]; const float* aim = a.in[10]; const float* ldt = a.in[11]; const float* bre = a.in[12]; const float* bim = a.in[13];
        const float* cre = a.in[14]; const float* cim = a.in[15];
        for (int idx = blockIdx.x * (NWAVES * 64) + tid; idx < 2 * 64 * 64; idx += G * NWAVES * 64) {
            const int dg = idx >> 6, p = idx & 63;
            const double ar = (double)are[idx], ai = (double)aim[idx];
            const double dtd = exp((double)ldt[dg]);
            const double mag = exp_small_d(ar * dtd);
            double sn, cs; sincos_d(ai * dtd, sn, cs);
            const double lr = mag * cs, li = mag * sn;
            const double den = ar * ar + ai * ai;
            const double cr = ((lr - 1.0) * ar + li * ai) / den, ci = (li * ar - (lr - 1.0) * ai) / den;
            LAM[2 * idx] = (float)lr; LAM[2 * idx + 1] = (float)li;
#pragma unroll
            for (int c = 0; c < 16; ++c) { const double br = (double)bre[(size_t)idx * 16 + c], bi = (double)bim[(size_t)idx * 16 + c];
#ifdef OLD_S5
                BBT[((size_t)dg * 128 + p) * 16 + c] = f2bf((float)(cr * br - ci * bi));
                BBT[((size_t)dg * 128 + 64 + p) * 16 + c] = f2bf((float)(cr * bi + ci * br)); }
#else
                BBT[((size_t)dg * 128 + 2 * p) * 16 + c] = f2bf((float)(cr * br - ci * bi));
                BBT[((size_t)dg * 128 + 2 * p + 1) * 16 + c] = f2bf((float)(cr * bi + ci * br)); }
#endif
#pragma unroll
            for (int c = 0; c < 16; ++c) { const size_t si = ((size_t)dg * 16 + c) * 64 + p;
#ifdef OLD_S5
                CT[((size_t)dg * 16 + c) * 128 + p] = f2bf(cre[si]); CT[((size_t)dg * 16 + c) * 128 + 64 + p] = f2bf(-cim[si]); }
#else
                CT[((size_t)dg * 16 + c) * 128 + 2 * p] = f2bf(cre[si]); CT[((size_t)dg * 16 + c) * 128 + 2 * p + 1] = f2bf(-cim[si]); }
#endif
        }
    }
}

__device__ __forceinline__ void norm_mod_rows(const float* src_lat, const float* src_ctx, int nrows, const float* mod, int sh_off, int sc_off, const float* gain, bf16_t* out, int gw, int NGW, int lane) {
    const int rows_per = (nrows + NGW - 1) / NGW;
    int m = gw * rows_per; const int mend = (m + rows_per < nrows) ? (m + rows_per) : nrows;
    if (m >= mend) return;
    f32x4 vn[4];
    { const float* row = (m < T) ? src_lat + (size_t)m * DM : src_ctx + (size_t)(m - T) * DM; const f32x4* xr = (const f32x4*)row + lane;
#pragma unroll
      for (int j = 0; j < 4; ++j) vn[j] = xr[64 * j]; }
    f32x4 g[4], sh[4], sc[4]; int b_loaded = -1;
    { const f32x4* g4 = (const f32x4*)gain + lane;
#pragma unroll
      for (int j = 0; j < 4; ++j) { g[j] = g4[64 * j]; sh[j] = g[j]; sc[j] = g[j]; } }
    for (; m < mend; ++m) {
        f32x4 v[4];
#pragma unroll
        for (int j = 0; j < 4; ++j) v[j] = vn[j];
        const int mn = m + 1;
        if (mn < mend) { const float* row = (mn < T) ? src_lat + (size_t)mn * DM : src_ctx + (size_t)(mn - T) * DM; const f32x4* xr = (const f32x4*)row + lane;
#pragma unroll
            for (int j = 0; j < 4; ++j) vn[j] = xr[64 * j]; }
        const int b = (m < T) ? (m >> 11) : 16;
        if (b != b_loaded) { b_loaded = b; const f32x4* sh4 = (const f32x4*)(mod + (size_t)b * NMOD + sh_off) + lane; const f32x4* sc4 = (const f32x4*)(mod + (size_t)b * NMOD + sc_off) + lane;
#pragma unroll
            for (int j = 0; j < 4; ++j) { sh[j] = sh4[64 * j]; sc[j] = 1.f + sc4[64 * j]; } }
        float s = 0.f;
#pragma unroll
        for (int j = 0; j < 4; ++j) s += (v[j].x * v[j].x + v[j].y * v[j].y) + (v[j].z * v[j].z + v[j].w * v[j].w);
        const float inv = rsqrtf(wave_sum(s) * (1.f / DM) + 1e-6f);
        u32x2* o8 = (u32x2*)(out + (size_t)m * DM) + lane;
#pragma unroll
        for (int j = 0; j < 4; ++j) { const f32x4 h = v[j] * inv * g[j] * sc[j] + sh[j];
            u32x2 o; o.x = pk2(h.x, h.y); o.y = pk2(h.z, h.w); o8[64 * j] = o; }
    }
}
__device__ __forceinline__ void final_norm_rows(float* io, const float* gain, int gw, int NGW, int lane) {
    int m = gw;
    if (m >= T) return;
    f32x4 vn[4];
    { const f32x4* xr = (const f32x4*)(io + (size_t)m * DM) + lane;
#pragma unroll
      for (int j = 0; j < 4; ++j) vn[j] = xr[64 * j]; }
    const f32x4* g4 = (const f32x4*)gain + lane;
    f32x4 gg[4];
#pragma unroll
    for (int j = 0; j < 4; ++j) gg[j] = g4[64 * j];
    for (; m < T; m += NGW) {
        f32x4 v[4];
#pragma unroll
        for (int j = 0; j < 4; ++j) v[j] = vn[j];
        const int mn = m + NGW;
        if (mn < T) { const f32x4* xr = (const f32x4*)(io + (size_t)mn * DM) + lane;
#pragma unroll
            for (int j = 0; j < 4; ++j) vn[j] = xr[64 * j]; }
        float s = 0.f;
#pragma unroll
        for (int j = 0; j < 4; ++j) s += (v[j].x * v[j].x + v[j].y * v[j].y) + (v[j].z * v[j].z + v[j].w * v[j].w);
        const float inv = rsqrtf(wave_sum(s) * (1.f / DM) + 1e-6f);
        f32x4* xo = (f32x4*)(io + (size_t)m * DM) + lane;
#pragma unroll
        for (int j = 0; j < 4; ++j) xo[64 * j] = v[j] * inv * gg[j];
    }
}

__device__ __forceinline__ void nb_of(int type, int t, int& delta, bool& valid) {
    if (type == 0) { delta = -1; valid = (t & 63) != 0; }
    else if (type == 1) { delta = 1; valid = (t & 63) != 63; }
    else if (type == 2) { delta = -64; valid = t >= 64; }
    else if (type == 3) { delta = 64; valid = t < SEQ - 64; }
    else if (type == 4) { delta = -1; valid = t > 0; }
    else { delta = 1; valid = t < CTXL - 1; }
}
template <class MuPtr>
__device__ __forceinline__ void load_lerp16(const bf16_t* rw, size_t m, int col, int delta, bool valid, MuPtr mu, float* out) {
    const u32x4* p = (const u32x4*)(rw + m * RWC + col);
    const u32x4 a0 = p[0], a1 = p[1];
    u32x4 n0 = (u32x4){0u, 0u, 0u, 0u}, n1 = n0;
    if (valid) { const u32x4* q = (const u32x4*)(rw + (size_t)((long)m + delta) * RWC + col); n0 = q[0]; n1 = q[1]; }
    float x[16], nb[16];
    unpack8(a0, x); unpack8(a1, x + 8); unpack8(n0, nb); unpack8(n1, nb + 8);
#pragma unroll
    for (int e = 0; e < 16; ++e) out[e] = x[e] + (nb[e] - x[e]) * mu[e];
}
template <class MuPtr>
__device__ __forceinline__ void load_lerp8(const bf16_t* rw, size_t m, int col, int delta, bool valid, MuPtr mu, float* out) {
    const u32x4 a0 = *(const u32x4*)(rw + m * RWC + col);
    u32x4 n0 = (u32x4){0u, 0u, 0u, 0u};
    if (valid) n0 = *(const u32x4*)(rw + (size_t)((long)m + delta) * RWC + col);
    float x[8], nb[8];
    unpack8(a0, x); unpack8(n0, nb);
#pragma unroll
    for (int e = 0; e < 8; ++e) out[e] = x[e] + (nb[e] - x[e]) * mu[e];
}

__device__ __forceinline__ void chunk_rows(int ci, int d, int b, bool& is_ctx, int& t0, size_t& rowbase) {
    is_ctx = ci < 16;
    if (is_ctx) { const int c = d ? 15 - ci : ci; t0 = 16 * c; rowbase = (size_t)T + (size_t)b * CTXL + t0; }
    else { const int c = d ? 127 - (ci - 16) : (ci - 16); t0 = 16 * c; rowbase = (size_t)b * SEQ + t0; }
}

#define XB_TMO      128
#define XB_XCNT(j)  (256  + 64 * (j))
#define XB_XSUB(j)  (1280 + 64 * (j))
#define XB_XGEN(j)  (2304 + 64 * (j))
#define XB_TOP      3328
#define XB_TOPGEN   3392
#define XCD_BAR_WORDS 3456
#define XB_SPIN_CAP (1u << 20)
__device__ __forceinline__ unsigned xb_ld(unsigned* p)              { return __hip_atomic_load(p, __ATOMIC_RELAXED, __HIP_MEMORY_SCOPE_AGENT); }
__device__ __forceinline__ unsigned xb_add(unsigned* p, unsigned v) { return __hip_atomic_fetch_add(p, v, __ATOMIC_RELAXED, __HIP_MEMORY_SCOPE_AGENT); }
__device__ __forceinline__ unsigned xb_xcc_id() { return (unsigned)__builtin_amdgcn_s_getreg((3 << 11) | 20) & 0xFu; }
#define XB_SPIN(cond, bar) do { unsigned _sp = 0; while (cond) { __builtin_amdgcn_s_sleep(1); \
    if ((++_sp & 255u) == 0u) { if (xb_ld(&(bar)[XB_TMO])) break; if (_sp > XB_SPIN_CAP) { atomicAdd(&(bar)[XB_TMO], 1u); break; } } } } while (0)
struct XcdBarrier { unsigned* bar; unsigned x; volatile LAS unsigned* st; };
__device__ __forceinline__ XcdBarrier xcd_barrier_post(unsigned* bar, volatile LAS unsigned* st) {
    XcdBarrier b; b.bar = bar; b.x = xb_xcc_id(); b.st = st;
    if (threadIdx.x == 0) (void)xb_add(&bar[XB_XCNT(b.x)], 1u);
    return b;
}
__device__ __forceinline__ void xcd_barrier_complete(unsigned* bar, unsigned x, unsigned& nloc, unsigned& nx) {
    const unsigned G = gridDim.x * gridDim.y * gridDim.z;
    unsigned sum, cnt, mine, sp = 0u;
    for (;;) {
        sum = 0u; cnt = 0u; mine = 0u;
#pragma unroll
        for (unsigned j = 0; j < 16; ++j) { const unsigned c = xb_ld(&bar[XB_XCNT(j)]); sum += c; cnt += (c > 0u) ? 1u : 0u; mine = (j == x) ? c : mine; }
        if (sum == G) break;
        __builtin_amdgcn_s_sleep(1);
        if ((++sp & 255u) == 0u) { if (xb_ld(&bar[XB_TMO])) break; if (sp > XB_SPIN_CAP) { atomicAdd(&bar[XB_TMO], 1u); break; } }
    }
    nloc = mine > 0u ? mine : 1u; nx = cnt > 0u ? cnt : 1u;
}
__device__ __forceinline__ void xcd_barrier(const XcdBarrier& b) {
    asm volatile("s_waitcnt vmcnt(0)" ::: "memory");
    __syncthreads();
    if (threadIdx.x == 0) {
        unsigned* bar = b.bar;
        __builtin_amdgcn_s_waitcnt(0);
        unsigned nloc = b.st[0], nx = b.st[1];
        if (nloc == 0u) { xcd_barrier_complete(bar, b.x, nloc, nx); b.st[0] = nloc; b.st[1] = nx; }
        const unsigned old = xb_add(&bar[XB_XSUB(b.x)], 1u);
        const unsigned gen = old / nloc;
        if (old + 1u == (gen + 1u) * nloc) {
            __builtin_amdgcn_fence(__ATOMIC_RELEASE, "agent");
            asm volatile("s_waitcnt vmcnt(0)" ::: "memory");
            const unsigned og = xb_add(&bar[XB_TOP], 1u);
            const unsigned tg = og / nx;
            if (og + 1u == (tg + 1u) * nx) xb_add(&bar[XB_TOPGEN], 1u);
            else XB_SPIN(xb_ld(&bar[XB_TOPGEN]) == tg, bar);
            __builtin_amdgcn_fence(__ATOMIC_ACQUIRE, "agent");
            xb_add(&bar[XB_XGEN(b.x)], 1u);
            asm volatile("s_waitcnt vmcnt(0)" ::: "memory");
        } else {
            XB_SPIN(xb_ld(&bar[XB_XGEN(b.x)]) == gen, bar);
            __builtin_amdgcn_fence(__ATOMIC_ACQUIRE, "agent");
            asm volatile("s_waitcnt vmcnt(0)" ::: "memory");
        }
    }
    __syncthreads();
}
#ifndef SCAN_UNROLL
#define SCAN_UNROLL 16
#endif
constexpr int OPS = 196;
constexpr int O_BKD = 64, O_A = 128, O_R = 160;
constexpr int VS = 68;
constexpr int YS = 36;
constexpr int SLOT_F = 16 * OPS + 16 * VS;
constexpr int NSLOT = 3;
constexpr int P3_RING = 0, P3_YB = 2 * NSLOT * SLOT_F * 4, P3_CST = P3_YB + 4 * 16 * YS * 4, P3_FLG = P3_CST + 4 * 2560, P3_ZERO = P3_FLG + 64, P3_END = P3_ZERO + 256, P3_S5_BYTES = 12800;
static_assert(P3_END <= LDS_BYTES - 64 && 4 * P3_S5_BYTES <= LDS_BYTES - 64, "P3 LDS maps");

__device__ __forceinline__ unsigned flag_ld(volatile LAS unsigned* p) { return (unsigned)__builtin_amdgcn_readfirstlane((int)*p); }
__device__ __forceinline__ void spin_ge(volatile LAS unsigned* p, unsigned need) {
    while (flag_ld(p) < need) __builtin_amdgcn_s_sleep(1);
    asm volatile("" ::: "memory");
}

struct Raw16 { u32x4 a0, a1, n0, n1; bool ok; };
struct Raw8 { u32x4 a0, n0; bool ok; };
__device__ __forceinline__ Raw16 ld_raw16(const bf16_t* rw, size_t m, int col, int delta, bool valid) {
    Raw16 r; const u32x4* p = (const u32x4*)(rw + m * RWC + col); const u32x4* q = (const u32x4*)(rw + (size_t)((long)m + (valid ? delta : 0)) * RWC + col);
    r.a0 = p[0]; r.a1 = p[1]; r.n0 = q[0]; r.n1 = q[1]; r.ok = valid; return r;
}
__device__ __forceinline__ Raw8 ld_raw8(const bf16_t* rw, size_t m, int col, int delta, bool valid) {
    Raw8 r; r.a0 = *(const u32x4*)(rw + m * RWC + col); r.n0 = *(const u32x4*)(rw + (size_t)((long)m + (valid ? delta : 0)) * RWC + col); r.ok = valid; return r;
}
template <class MuPtr> __device__ __forceinline__ void lerp16(const Raw16& r, MuPtr mu, float* out) {
    const u32x4 z = (u32x4){0u, 0u, 0u, 0u};
    float x[16], nb[16]; unpack8(r.a0, x); unpack8(r.a1, x + 8); unpack8(r.ok ? r.n0 : z, nb); unpack8(r.ok ? r.n1 : z, nb + 8);
#pragma unroll
    for (int e = 0; e < 16; ++e) out[e] = x[e] + (nb[e] - x[e]) * mu[e];
}
template <class MuPtr> __device__ __forceinline__ void lerp8(const Raw8& r, MuPtr mu, float* out) {
    const u32x4 z = (u32x4){0u, 0u, 0u, 0u};
    float x[8], nb[8]; unpack8(r.a0, x); unpack8(r.ok ? r.n0 : z, nb);
#pragma unroll
    for (int e = 0; e < 8; ++e) out[e] = x[e] + (nb[e] - x[e]) * mu[e];
}

__device__ __forceinline__ void wkv_prep_wave(const Args& a, LAS float* ring, LAS float* cst, volatile LAS unsigned* ready, volatile LAS unsigned* done0, volatile LAS unsigned* done1,
                                              int chain, unsigned seq0, int parity, int cstep, int lane) {
    unsigned char* ws = a.ws;
    const bf16_t* rw = (const bf16_t*)(ws + WS_RW);
    const int d = chain & 1, h = (chain >> 1) & 15, b = chain >> 5;
    float* BETA = (float*)(ws + WS_BETA);
    {
        const float* mu = a.in[18];
        cst[0 * 64 + lane] = mu[64 * h + lane]; cst[1 * 64 + lane] = mu[1024 + 64 * h + lane]; cst[2 * 64 + lane] = mu[2048 + 64 * h + lane];
        cst[3 * 64 + lane] = a.in[24][64 * h + lane]; cst[4 * 64 + lane] = a.in[25][64 * h + lane]; cst[5 * 64 + lane] = a.in[26][(d * 16 + h) * 64 + lane];
        cst[6 * 64 + lane] = a.in[19][d * 1024 + 64 * h + lane]; cst[7 * 64 + lane] = a.in[21][d * 1024 + 64 * h + lane];
        cst[8 * 64 + lane] = mu[3072 + lane]; cst[9 * 64 + lane] = mu[3136 + lane];
    }
    WAVE_SYNC();
    const int tk = lane & 15, sg = lane >> 4;
    bf16x8 WUP[4][2], AUP[4][2];
    {
        const bf16_t* wupt = (const bf16_t*)(ws + WS_WUPT) + (size_t)d * 1024 * 64; const bf16_t* aupt = (const bf16_t*)(ws + WS_AUPT) + (size_t)d * 1024 * 64;
#pragma unroll
        for (int nt = 0; nt < 4; ++nt)
#pragma unroll
            for (int ks = 0; ks < 2; ++ks) { const int n = 64 * h + 16 * (tk >> 2) + 4 * nt + (tk & 3);
                WUP[nt][ks] = *(const bf16x8*)(wupt + (size_t)n * 64 + 32 * ks + 8 * sg); AUP[nt][ks] = *(const bf16x8*)(aupt + (size_t)n * 64 + 32 * ks + 8 * sg); }
    }
    for (int ci = parity; ci < 144; ci += cstep) {
        bool is_ctx; int t0; size_t rowbase; chunk_rows(ci, d, b, is_ctx, t0, rowbase);
        const int type_r = is_ctx ? 4 : (h < 13 ? 0 : 1), type_k = is_ctx ? (h < 10 ? 4 : 5) : (h < 10 ? 1 : 2), type_v = is_ctx ? 5 : (h < 7 ? 2 : 3), type_w = is_ctx ? 5 : 3;
        const int t = t0 + tk; const size_t m = rowbase + tk;
        int dl; bool vd;
        nb_of(type_w, t, dl, vd);
        const Raw8 rwd0 = ld_raw8(rw, m, 3072 + 8 * sg, dl, vd), rwd1 = ld_raw8(rw, m, 3072 + 32 + 8 * sg, dl, vd);
        const Raw8 rad0 = ld_raw8(rw, m, 3136 + 8 * sg, dl, vd), rad1 = ld_raw8(rw, m, 3136 + 32 + 8 * sg, dl, vd);
        nb_of(type_k, t, dl, vd); const Raw16 rk = ld_raw16(rw, m, 1024 + 64 * h + 16 * sg, dl, vd);
        nb_of(type_r, t, dl, vd); const Raw16 rr = ld_raw16(rw, m, 64 * h + 16 * sg, dl, vd);
        bf16x8 wfr[2], afr[2];
        { float xw[8], xa[8];
          lerp8(rwd0, cst + 8 * 64 + 8 * sg, xw); lerp8(rad0, cst + 9 * 64 + 8 * sg, xa);
#pragma unroll
          for (int e = 0; e < 8; ++e) xw[e] = tanh_(xw[e]);
          wfr[0] = as_bf16x8(pack8(xw)); afr[0] = as_bf16x8(pack8(xa));
          lerp8(rwd1, cst + 8 * 64 + 32 + 8 * sg, xw); lerp8(rad1, cst + 9 * 64 + 32 + 8 * sg, xa);
#pragma unroll
          for (int e = 0; e < 8; ++e) xw[e] = tanh_(xw[e]);
          wfr[1] = as_bf16x8(pack8(xw)); afr[1] = as_bf16x8(pack8(xa)); }
        nb_of(type_v, t, dl, vd); const Raw16 rv = ld_raw16(rw, m, 2048 + 64 * h + 16 * sg, dl, vd);
        f32x4 accw[4], acca[4];
#pragma unroll
        for (int nt = 0; nt < 4; ++nt) { accw[nt] = (f32x4){0.f, 0.f, 0.f, 0.f}; acca[nt] = accw[nt];
#pragma unroll
            for (int ks = 0; ks < 2; ++ks) { accw[nt] = __builtin_amdgcn_mfma_f32_16x16x32_bf16(WUP[nt][ks], wfr[ks], accw[nt], 0, 0, 0);
                acca[nt] = __builtin_amdgcn_mfma_f32_16x16x32_bf16(AUP[nt][ks], afr[ks], acca[nt], 0, 0, 0); } }
        const unsigned seq = seq0 + (unsigned)ci;
        if (seq >= (unsigned)NSLOT) { spin_ge(done0, seq - (unsigned)NSLOT + 1u); spin_ge(done1, seq - (unsigned)NSLOT + 1u); }
        LAS float* slot = ring + (seq % (unsigned)NSLOT) * SLOT_F;
        LAS float* ow = slot + tk * OPS + 16 * sg;
        float aa[16];
        { float dec[16];
#pragma unroll
          for (int e = 0; e < 16; ++e) { const float x = cst[6 * 64 + 16 * sg + e] + accw[e >> 2][e & 3];
              dec[e] = __expf(-0.6065306597126334f * sigm(x));
              aa[e] = sigm(cst[7 * 64 + 16 * sg + e] + acca[e >> 2][e & 3]); }
#pragma unroll
          for (int q = 0; q < 4; ++q) *(LAS f32x4*)(ow + 0 * 64 + 4 * q) = (f32x4){dec[4 * q], dec[4 * q + 1], dec[4 * q + 2], dec[4 * q + 3]}; }
        float kd[16];
        { float xk[16], kk[16]; float ssq = 0.f;
          lerp16(rk, cst + 1 * 64 + 16 * sg, xk);
#pragma unroll
          for (int e = 0; e < 16; ++e) { kk[e] = xk[e] * cst[3 * 64 + 16 * sg + e]; ssq += kk[e] * kk[e]; kd[e] = xk[e] * (1.f + (aa[e] - 1.f) * cst[4 * 64 + 16 * sg + e]); }
          ssq += __shfl_xor(ssq, 16); ssq += __shfl_xor(ssq, 32);
          const float inv = rsqrtf(fmaxf(ssq, 1e-24f));
          { float na[16];
#pragma unroll
            for (int e = 0; e < 16; ++e) { kk[e] *= inv; na[e] = -kk[e]; }
            LAS u32x4* ab = (LAS u32x4*)(slot + tk * OPS + O_A + 8 * sg);
            ab[0] = pack8(na); ab[1] = pack8(na + 8); }
#pragma unroll
          for (int q = 0; q < 4; ++q) { u32x4 w4;
              w4.x = pk2(kk[4 * q] * aa[4 * q], kd[4 * q]); w4.y = pk2(kk[4 * q + 1] * aa[4 * q + 1], kd[4 * q + 1]); w4.z = pk2(kk[4 * q + 2] * aa[4 * q + 2], kd[4 * q + 2]); w4.w = pk2(kk[4 * q + 3] * aa[4 * q + 3], kd[4 * q + 3]);
              *(LAS u32x4*)(ow + O_BKD + 4 * q) = w4; } }
        { float xr[16]; float bet = 0.f;
          lerp16(rr, cst + 0 * 64 + 16 * sg, xr);
#pragma unroll
          for (int e = 0; e < 16; ++e) bet += xr[e] * kd[e] * cst[5 * 64 + 16 * sg + e];
          bet += __shfl_xor(bet, 16); bet += __shfl_xor(bet, 32);
          LAS u32x4* rb = (LAS u32x4*)(slot + tk * OPS + O_R + 8 * sg);
          rb[0] = pack8(xr); rb[1] = pack8(xr + 8);
          if (!is_ctx && sg == 0) BETA[((size_t)d * T + m) * 16 + h] = bet; }
        { float xv[16];
          lerp16(rv, cst + 2 * 64 + 16 * sg, xv);
#pragma unroll
          for (int q = 0; q < 4; ++q) *(LAS f32x4*)(slot + 16 * OPS + tk * VS + 16 * sg + 4 * q) = (f32x4){xv[4 * q], xv[4 * q + 1], xv[4 * q + 2], xv[4 * q + 3]}; }
        WAVE_SYNC();
        spin_ge(ready, seq);
        if (lane == 0) *ready = seq + 1u;
        asm volatile("" ::: "memory");
    }
}

struct WkvOps { f32x4 w4[4]; unsigned bk[4]; float v0, v1; u32x4 af[2]; };
__device__ __forceinline__ WkvOps wkv_load_ops(const LAS float* ob, const LAS float* vrow, const LAS float* xsrc, const LAS float* fsrc, int kq) {
    WkvOps o;
#pragma unroll
    for (int kt = 0; kt < 4; ++kt) { o.w4[kt] = *(const LAS f32x4*)(ob + 16 * kt + 4 * kq); o.bk[kt] = *(const LAS unsigned*)(xsrc + 16 * kt); }
    o.v0 = vrow[0]; o.v1 = vrow[16];
#pragma unroll
    for (int ks = 0; ks < 2; ++ks) { const u32x2 lo = *(const LAS u32x2*)(fsrc + 16 * ks + 2 * kq), hi = *(const LAS u32x2*)(fsrc + 16 * ks + 8 + 2 * kq);
        o.af[ks] = (u32x4){lo.x, lo.y, hi.x, hi.y}; }
    return o;
}
__device__ __forceinline__ void wkv_scan_wave(const Args& a, LAS float* ring, LAS float* yb, const LAS float* zline, volatile LAS unsigned* ready, volatile LAS unsigned* done, int chain, int hw, unsigned seq0, int lane) {
    const int d = chain & 1, h = (chain >> 1) & 15, b = chain >> 5;
    bf16_t* Yd = (bf16_t*)a.out + (size_t)d * T * DM;
    const int vi = lane & 15, kq = lane >> 4, role = vi & 3;
    f32x4 Tt[4][2];
#pragma unroll
    for (int i = 0; i < 4; ++i)
#pragma unroll
        for (int j = 0; j < 2; ++j) Tt[i][j] = (f32x4){0.f, 0.f, 0.f, 0.f};
    u32x4 rl[2] = {(u32x4){0u, 0u, 0u, 0u}, (u32x4){0u, 0u, 0u, 0u}};
    bool prev_lat = false; size_t prev_rowbase = 0;
    const int ftok = lane >> 2, fpc = lane & 3;
#define WKV_FLUSH(RB) do { WAVE_SYNC(); \
        const f32x4 y0 = *(const LAS f32x4*)(yb + ftok * YS + 8 * fpc), y1 = *(const LAS f32x4*)(yb + ftok * YS + 8 * fpc + 4); \
        u32x4 o; o.x = pk2(y0.x, y0.y); o.y = pk2(y0.z, y0.w); o.z = pk2(y1.x, y1.y); o.w = pk2(y1.z, y1.w); \
        *(u32x4*)(Yd + ((RB) + ftok) * DM + 64 * h + 32 * hw + 8 * fpc) = o; WAVE_SYNC(); } while (0)
#define WKV_PASS(AF, SA, YV) do { _Pragma("unroll") for (int rt = 0; rt < 2; ++rt) { f32x4 acc = (f32x4){0.f, 0.f, 0.f, 0.f}; \
            _Pragma("unroll") for (int ks = 0; ks < 2; ++ks) { u32x4 sb; sb.x = pk2(Tt[2 * ks][rt].x, Tt[2 * ks][rt].y); sb.y = pk2(Tt[2 * ks][rt].z, Tt[2 * ks][rt].w); sb.z = pk2(Tt[2 * ks + 1][rt].x, Tt[2 * ks + 1][rt].y); sb.w = pk2(Tt[2 * ks + 1][rt].z, Tt[2 * ks + 1][rt].w); \
                acc = __builtin_amdgcn_mfma_f32_16x16x32_bf16(as_bf16x8((AF)[ks]), as_bf16x8(sb), acc, 0, 0, 0); } \
            SA[rt] = acc[0]; YV[rt] = acc[1]; } } while (0)
#define WKV_FSRC(OBC, OBP) ((role == 0) ? ((OBC) + O_A) : ((role == 1) ? ((OBP) + O_R) : zline))
#define WKV_XSRC(OBC) ((OBC) + O_BKD + 4 * kq + (vi & 3))
    for (int ci = 0; ci < 144; ++ci) {
        bool is_ctx; int t0; size_t rowbase; chunk_rows(ci, d, b, is_ctx, t0, rowbase);
        const unsigned seq = seq0 + (unsigned)ci;
        spin_ge(ready, seq + 1u);
        const LAS float* slot = ring + (seq % (unsigned)NSLOT) * SLOT_F;
        const LAS float* vbase = slot + 16 * OPS + 32 * hw + vi;
        const int tok0 = d ? 15 : 0;
        WkvOps cur = wkv_load_ops(slot + tok0 * OPS, vbase + tok0 * VS, WKV_XSRC(slot + tok0 * OPS), (role == 0) ? (slot + tok0 * OPS + O_A) : zline, kq);
        if (role == 1) { cur.af[0] = rl[0]; cur.af[1] = rl[1]; }
#pragma unroll SCAN_UNROLL
        for (int s = 0; s < 16; ++s) {
            const int tok = d ? 15 - s : s;
            const LAS float* ob = slot + tok * OPS;
            WkvOps nxt = cur;
            if (s < 15) { const int tn = d ? tok - 1 : tok + 1; nxt = wkv_load_ops(slot + tn * OPS, vbase + tn * VS, WKV_XSRC(slot + tn * OPS), WKV_FSRC(slot + tn * OPS, ob), kq); }
            __builtin_amdgcn_sched_barrier(0);
            float sa[2], yv[2];
            WKV_PASS(cur.af, sa, yv);
            if (s == 0) { if (prev_lat) { if (kq == 0) { const int pt = d ? 0 : 15; yb[pt * YS + vi] = yv[0]; yb[pt * YS + 16 + vi] = yv[1]; } WKV_FLUSH(prev_rowbase); } }
            else if (!is_ctx) { if (kq == 0) { const int pt = d ? tok + 1 : tok - 1; yb[pt * YS + vi] = yv[0]; yb[pt * YS + 16 + vi] = yv[1]; } }
            typedef short bf16x4_t __attribute__((ext_vector_type(4)));
            u32x2 yf[2];
#pragma unroll
            for (int rt = 0; rt < 2; ++rt) { const unsigned pr = pk2(sa[rt], rt ? cur.v1 : cur.v0); yf[rt] = (u32x2){pr, 0u}; }
#pragma unroll
            for (int kt = 0; kt < 4; ++kt) { const u32x2 xf = (u32x2){cur.bk[kt], 0u};
#pragma unroll
                for (int rt = 0; rt < 2; ++rt) { const f32x4 c = Tt[kt][rt] * cur.w4[kt];
                    Tt[kt][rt] = __builtin_amdgcn_mfma_f32_4x4x4bf16_1k(__builtin_bit_cast(bf16x4_t, xf), __builtin_bit_cast(bf16x4_t, yf[rt]), c, 0, 0, 0); } }
            cur = nxt;
        }
        { const LAS float* fs = (role == 1) ? (slot + (d ? 0 : 15) * OPS + O_R) : zline;
#pragma unroll
          for (int ks = 0; ks < 2; ++ks) { const u32x2 lo = *(const LAS u32x2*)(fs + 16 * ks + 2 * kq), hi = *(const LAS u32x2*)(fs + 16 * ks + 8 + 2 * kq); rl[ks] = (u32x4){lo.x, lo.y, hi.x, hi.y}; } }
        WAVE_SYNC();
        if (lane == 0) *done = seq + 1u;
        asm volatile("" ::: "memory");
        prev_lat = !is_ctx; prev_rowbase = rowbase;
    }
    {
        u32x4 af[2];
        af[0] = (role == 1) ? rl[0] : (u32x4){0u, 0u, 0u, 0u}; af[1] = (role == 1) ? rl[1] : (u32x4){0u, 0u, 0u, 0u};
        float sa[2], yv[2];
        WKV_PASS(af, sa, yv); (void)sa;
        if (kq == 0) { const int pt = d ? 0 : 15; yb[pt * YS + vi] = yv[0]; yb[pt * YS + 16 + vi] = yv[1]; }
        WKV_FLUSH(prev_rowbase);
    }
#undef WKV_FLUSH
#undef WKV_PASS
#undef WKV_FSRC
#undef WKV_XSRC
}

constexpr int BUS = 132;
constexpr int HS = 136;
__device__ __forceinline__ void s5_chain(const Args& a, LAS float* buL, LAS bf16_t* HL, int chain, int lane) {
    unsigned char* ws = a.ws;
    const int d = chain & 1, g = (chain >> 1) & 63, b = chain >> 7;
    const bf16_t* U = (const bf16_t*)(ws + WS_U); bf16_t* PO = (bf16_t*)(ws + WS_YG);
    const bf16_t* ESRC = d ? (const bf16_t*)PO : U;
    const float* LAM = (const float*)(ws + WS_LAM); const bf16_t* BBT = (const bf16_t*)(ws + WS_BBT); const bf16_t* CT = (const bf16_t*)(ws + WS_CT);
    const int fr = lane & 15, fq = lane >> 4;
    const int dg = d * 64 + g;
    const f32x4 s5d = *(const f32x4*)(a.in[16] + g * 16 + 4 * fq);
    const float lr = LAM[2 * (dg * 64 + lane)], li = LAM[2 * (dg * 64 + lane) + 1];
    typedef short bf16x4_t __attribute__((ext_vector_type(4)));
    bf16x4_t bfr[8]; bf16x8 cfr[4];
#pragma unroll
    for (int nt = 0; nt < 8; ++nt) bfr[nt] = __builtin_bit_cast(bf16x4_t, *(const u32x2*)(BBT + ((size_t)dg * 128 + 16 * nt + fr) * 16 + 4 * fq));
#pragma unroll
    for (int ks = 0; ks < 4; ++ks) cfr[ks] = *(const bf16x8*)(CT + ((size_t)dg * 16 + fr) * 128 + 32 * ks + 8 * fq);
    float hr = 0.f, hi = 0.f;
    u32x2 uvn[4]; u32x2 en[4];
#pragma unroll
    for (int j = 0; j < 4; ++j) { bool ic; int t0; size_t rb; chunk_rows(j, d, b, ic, t0, rb); uvn[j] = *(const u32x2*)(U + (rb + fr) * DM + g * 16 + 4 * fq); en[j] = (u32x2){0u, 0u}; }
    for (int grp = 0; grp < 36; ++grp) {
        u32x2 uvc[4]; u32x2 ec[4];
#pragma unroll
        for (int j = 0; j < 4; ++j) { uvc[j] = uvn[j]; ec[j] = en[j];
            asm volatile("" : "+v"(uvc[j]), "+v"(ec[j])); }
        if (grp + 1 < 36) {
#pragma unroll
            for (int j = 0; j < 4; ++j) { bool ic; int t1; size_t rb; chunk_rows(4 * (grp + 1) + j, d, b, ic, t1, rb);
                uvn[j] = *(const u32x2*)(U + (rb + fr) * DM + g * 16 + 4 * fq);
                en[j] = *(const u32x2*)(ESRC + (rb + fr) * DM + g * 16 + 4 * fq); (void)ic; } }
#pragma unroll
        for (int j = 0; j < 4; ++j) {
            const int ci = 4 * grp + j;
            bool is_ctx; int t0; size_t rowbase; chunk_rows(ci, d, b, is_ctx, t0, rowbase);
            const u32x2 e_c = ec[j];
            const bf16x4_t ufr = __builtin_bit_cast(bf16x4_t, uvc[j]);
            { f32x4 dacc[8];
#pragma unroll
              for (int nt = 0; nt < 8; ++nt) dacc[nt] = __builtin_amdgcn_mfma_f32_16x16x16bf16_1k(bfr[nt], ufr, (f32x4){0.f, 0.f, 0.f, 0.f}, 0, 0, 0);
              __builtin_amdgcn_sched_barrier(0);
#pragma unroll
              for (int nt = 0; nt < 8; ++nt) *(LAS f32x4*)(buL + fr * BUS + 16 * nt + 4 * fq) = dacc[nt]; }
            WAVE_SYNC();
            f32x2 bu[16];
#pragma unroll
            for (int s2 = 0; s2 < 16; ++s2) { const int tok = d ? 15 - s2 : s2; bu[s2] = *(const LAS f32x2*)(buL + tok * BUS + 2 * lane); }
            { f32x2 hv = (f32x2){hr, hi}; const f32x2 L1 = (f32x2){lr, lr}, L2 = (f32x2){-li, li};
#pragma unroll
              for (int s2 = 0; s2 < 16; ++s2) { const int tok = d ? 15 - s2 : s2;
                  const f32x2 hs = __builtin_shufflevector(hv, hv, 1, 0);
                  hv = L2 * hs + (L1 * hv + bu[s2]);
                  ((LAS unsigned*)HL)[tok * (HS / 2) + lane] = pk2(hv.x, hv.y); }
              hr = hv.x; hi = hv.y; }
            WAVE_SYNC();
            if (!is_ctx) {
                f32x4 yacc = (f32x4){0.f, 0.f, 0.f, 0.f};
#pragma unroll
                for (int ks = 0; ks < 4; ++ks) { const bf16x8 hfr = *(const LAS bf16x8*)(HL + fr * HS + 32 * ks + 8 * fq);
                    yacc = __builtin_amdgcn_mfma_f32_16x16x32_bf16(cfr[ks], hfr, yacc, 0, 0, 0); }
                if (d == 0) { yacc[0] += bf_lo(e_c.x) * s5d[0]; yacc[1] += bf_hi(e_c.x) * s5d[1]; yacc[2] += bf_lo(e_c.y) * s5d[2]; yacc[3] += bf_hi(e_c.y) * s5d[3]; }
                else { yacc[0] = gelu_tanh(yacc[0] + bf_lo(e_c.x)); yacc[1] = gelu_tanh(yacc[1] + bf_hi(e_c.x)); yacc[2] = gelu_tanh(yacc[2] + bf_lo(e_c.y)); yacc[3] = gelu_tanh(yacc[3] + bf_hi(e_c.y)); }
                u32x2 o; o.x = pk2(yacc[0], yacc[1]); o.y = pk2(yacc[2], yacc[3]);
                *(u32x2*)(PO + (rowbase + fr) * DM + g * 16 + 4 * fq) = o;
                WAVE_SYNC();
            }
        }
    }
}
__device__ __forceinline__ void s5_combine(const Args& a, int gtid, int GT) {
    const u32x4* P0 = (const u32x4*)a.out; u32x4* YG = (u32x4*)(a.ws + WS_YG); const u32x4* P1 = YG;
    for (int i = gtid; i < T * DM / 8; i += GT) { float x0[8], x1[8], o[8]; unpack8(P0[i], x0); unpack8(P1[i], x1);
#pragma unroll
        for (int e = 0; e < 8; ++e) o[e] = gelu_tanh(x0[e] + x1[e]);
        YG[i] = pack8(o); }
}

#ifdef OLD_S5
__device__ __forceinline__ void s5_item(const Args& a, LAS float* buL, LAS bf16_t* HL, int item, int lane) {
    unsigned char* ws = a.ws;
    const int b = item >> 6, g = item & 63;
    const bf16_t* U = (const bf16_t*)(ws + WS_U); bf16_t* YG = (bf16_t*)(ws + WS_YG);
    const float* LAM = (const float*)(ws + WS_LAM); const bf16_t* BBT = (const bf16_t*)(ws + WS_BBT); const bf16_t* CT = (const bf16_t*)(ws + WS_CT);
    const int fr = lane & 15, fq = lane >> 4;
    const float s5d = a.in[16][g * 16 + fr];
    for (int d = 0; d < 2; ++d) {
        const int dg = d * 64 + g;
        const float lr = LAM[2 * (dg * 64 + lane)], li = LAM[2 * (dg * 64 + lane) + 1];
        bf16x8 bfr[8], cfr[4];
#pragma unroll
        for (int nt = 0; nt < 8; ++nt) { u32x4 v = (u32x4){0u, 0u, 0u, 0u}; if (fq < 2) v = *(const u32x4*)(BBT + ((size_t)dg * 128 + 16 * nt + fr) * 16 + 8 * fq); bfr[nt] = as_bf16x8(v); }
#pragma unroll
        for (int ks = 0; ks < 4; ++ks) cfr[ks] = *(const bf16x8*)(CT + ((size_t)dg * 16 + fr) * 128 + 32 * ks + 8 * fq);
        const bf16_t* ESRC = d ? (const bf16_t*)YG : U;
        float hr = 0.f, hi = 0.f;
        u32x4 uv_n; bf16_t e_n[4];
        { bool ic; int t0; size_t rb; chunk_rows(0, d, b, ic, t0, rb);
          uv_n = *(const u32x4*)(U + (rb + fr) * DM + g * 16 + 8 * (fq & 1));
#pragma unroll
          for (int j = 0; j < 4; ++j) e_n[j] = 0; }
        for (int ci = 0; ci < 144; ++ci) {
            bool is_ctx; int t0; size_t rowbase; chunk_rows(ci, d, b, is_ctx, t0, rowbase);
            u32x4 uv = uv_n; bf16_t e_c[4];
#pragma unroll
            for (int j = 0; j < 4; ++j) e_c[j] = e_n[j];
            if (ci + 1 < 144) { bool ic; int t1; size_t rb; chunk_rows(ci + 1, d, b, ic, t1, rb);
                uv_n = *(const u32x4*)(U + (rb + fr) * DM + g * 16 + 8 * (fq & 1));
                if (!ic) {
#pragma unroll
                    for (int j = 0; j < 4; ++j) e_n[j] = ESRC[(rb + 4 * fq + j) * DM + g * 16 + fr]; } }
            if (fq >= 2) uv = (u32x4){0u, 0u, 0u, 0u};
            const bf16x8 ufr = as_bf16x8(uv);
#pragma unroll
            for (int nt = 0; nt < 8; ++nt) { f32x4 acc = (f32x4){0.f, 0.f, 0.f, 0.f};
                acc = __builtin_amdgcn_mfma_f32_16x16x32_bf16(ufr, bfr[nt], acc, 0, 0, 0);
#pragma unroll
                for (int j = 0; j < 4; ++j) buL[(4 * fq + j) * BUS + 16 * nt + fr] = acc[j]; }
            WAVE_SYNC();
            float br[16], bi[16];
#pragma unroll
            for (int s = 0; s < 16; ++s) { const int tok = d ? 15 - s : s; br[s] = buL[tok * BUS + lane]; bi[s] = buL[tok * BUS + 64 + lane]; }
#pragma unroll
            for (int s = 0; s < 16; ++s) { const int tok = d ? 15 - s : s;
                const float nr = lr * hr - li * hi + br[s], ni = lr * hi + li * hr + bi[s]; hr = nr; hi = ni;
                if (!is_ctx) { HL[tok * HS + lane] = f2bf(hr); HL[tok * HS + 64 + lane] = f2bf(hi); } }
            WAVE_SYNC();
            if (is_ctx) continue;
            f32x4 yacc = (f32x4){0.f, 0.f, 0.f, 0.f};
#pragma unroll
            for (int ks = 0; ks < 4; ++ks) { const bf16x8 afr = *(const LAS bf16x8*)(HL + fr * HS + 32 * ks + 8 * fq);
                yacc = __builtin_amdgcn_mfma_f32_16x16x32_bf16(afr, cfr[ks], yacc, 0, 0, 0); }
#pragma unroll
            for (int j = 0; j < 4; ++j) { const size_t off = (rowbase + 4 * fq + j) * DM + g * 16 + fr;
                if (d == 0) { YG[off] = f2bf(yacc[j] + bf2f(e_c[j]) * s5d); }
                else { YG[off] = f2bf(gelu_tanh(yacc[j] + bf2f(e_c[j]))); } }
            WAVE_SYNC();
        }
    }
}

#endif
__device__ __forceinline__ void wkv_readout(const Args& a, int gw, int NGW, int lane) {
    unsigned char* ws = a.ws;
    const bf16_t* rw = (const bf16_t*)(ws + WS_RW); const bf16_t* GUPT = (const bf16_t*)(ws + WS_GUPT);
    const bf16_t* Y0 = (const bf16_t*)a.out; const bf16_t* Y1 = Y0 + (size_t)T * DM;
    const float* BETA = (const float*)(ws + WS_BETA); bf16_t* RPRE = (bf16_t*)(ws + WS_RPRE);
    const float* mu = a.in[18]; const float* lng = a.in[27]; const float* lnb = a.in[28];
    const int tk = lane & 15, sg = lane >> 4;
    const bool fixed_h = (NGW & 15) == 0;
    bf16x8 wfrc[4][4];
    if (fixed_h) { const int h0 = gw & 15;
#pragma unroll
        for (int ks = 0; ks < 4; ++ks)
#pragma unroll
            for (int nt = 0; nt < 4; ++nt) { const int n = 64 * h0 + 16 * (tk >> 2) + 4 * nt + (tk & 3); wfrc[ks][nt] = *(const bf16x8*)(GUPT + (size_t)n * 128 + 32 * ks + 8 * sg); } }
    for (int item = gw; item < (T / 16) * 16; item += NGW) {
        const int tile = item >> 4, h = item & 15;
        const size_t m = (size_t)tile * 16 + tk; const int t = (int)(m & (SEQ - 1));
        f32x4 accg[4];
#pragma unroll
        for (int nt = 0; nt < 4; ++nt) accg[nt] = (f32x4){0.f, 0.f, 0.f, 0.f};
        { int dl; bool vd; nb_of(3, t, dl, vd);
#pragma unroll
          for (int ks = 0; ks < 4; ++ks) { float xg[8];
              load_lerp8(rw, m, 3200 + 32 * ks + 8 * sg, dl, vd, mu + 3200 + 32 * ks + 8 * sg, xg);
#pragma unroll
              for (int e = 0; e < 8; ++e) xg[e] = sigm(xg[e]);
              const bf16x8 gfr = as_bf16x8(pack8(xg));
#pragma unroll
              for (int nt = 0; nt < 4; ++nt) { const int n = 64 * h + 16 * (tk >> 2) + 4 * nt + (tk & 3);
                  const bf16x8 wfr = fixed_h ? wfrc[ks][nt] : *(const bf16x8*)(GUPT + (size_t)n * 128 + 32 * ks + 8 * sg);
                  accg[nt] = __builtin_amdgcn_mfma_f32_16x16x32_bf16(wfr, gfr, accg[nt], 0, 0, 0); } } }
        const int col = 64 * h + 16 * sg;
        float y0[16], y1[16], wk[16];
        { const u32x4* p0 = (const u32x4*)(Y0 + m * DM + col); const u32x4* p1 = (const u32x4*)(Y1 + m * DM + col);
          unpack8(p0[0], y0); unpack8(p0[1], y0 + 8); unpack8(p1[0], y1); unpack8(p1[1], y1 + 8); }
        float s = 0.f;
#pragma unroll
        for (int e = 0; e < 16; ++e) { wk[e] = y0[e] + y1[e]; s += wk[e]; }
        s += __shfl_xor(s, 16); s += __shfl_xor(s, 32);
        const float mean = s * (1.f / 64);
        float s2 = 0.f;
#pragma unroll
        for (int e = 0; e < 16; ++e) { wk[e] -= mean; s2 += wk[e] * wk[e]; }
        s2 += __shfl_xor(s2, 16); s2 += __shfl_xor(s2, 32);
        const float rstd = rsqrtf(s2 * (1.f / 64) + 64e-5f);
        float xv[16];
        { int dl; bool vd; nb_of(h < 7 ? 2 : 3, t, dl, vd); load_lerp16(rw, m, 2048 + col, dl, vd, mu + 2048 + col, xv); }
        const float beta = BETA[m * 16 + h] + BETA[((size_t)T + m) * 16 + h];
        float o[16];
#pragma unroll
        for (int e = 0; e < 16; ++e) { const float yn = wk[e] * rstd * lng[col + e] + lnb[col + e]; o[e] = (yn + beta * xv[e]) * accg[e >> 2][e & 3]; }
        u32x4* op = (u32x4*)(RPRE + m * DM + col);
        op[0] = pack8(o); op[1] = pack8(o + 8);
    }
}

__device__ __forceinline__ void conv_act(const Args& a, const bf16_t* ZP, bf16_t* ACT, int nrows, int gw, int NGW, int lane) {
    const float* cw = a.in[32]; const float* cb = a.in[33];
    constexpr int RUN = 16;
    const int nitems = (nrows / RUN) * 6;
    for (int item = gw; item < nitems; item += NGW) {
        const int run = item / 6, gb = item % 6;
        const int gi = gb * 64 + lane;
        if (gi >= DFF / 8) continue;
        const int pn = gi >> 4, j0 = (gi & 15) * 8;
        const int zc = 256 * pn + j0;
        const int cg_ = 128 * pn + j0;
        float wg[3][8], wv[3][8], bg[8], bv[8];
#pragma unroll
        for (int k = 0; k < 3; ++k)
#pragma unroll
            for (int e = 0; e < 8; ++e) { wg[k][e] = cw[k * 2 * DFF + cg_ + e]; wv[k][e] = cw[k * 2 * DFF + DFF + cg_ + e]; }
#pragma unroll
        for (int e = 0; e < 8; ++e) { bg[e] = cb[cg_ + e]; bv[e] = cb[DFF + cg_ + e]; }
        const int r0 = run * RUN;
        const int tseq = r0 & (SEQ - 1);
        float pg[8], pv[8], cgv[8], cvv[8], ng[8], nv[8];
        if (tseq > 0) { unpack8(*(const u32x4*)(ZP + (size_t)(r0 - 1) * (2 * DFF) + zc), pg); unpack8(*(const u32x4*)(ZP + (size_t)(r0 - 1) * (2 * DFF) + zc + 128), pv); }
        else {
#pragma unroll
            for (int e = 0; e < 8; ++e) { pg[e] = 0.f; pv[e] = 0.f; } }
        unpack8(*(const u32x4*)(ZP + (size_t)r0 * (2 * DFF) + zc), cgv); unpack8(*(const u32x4*)(ZP + (size_t)r0 * (2 * DFF) + zc + 128), cvv);
        for (int i = 0; i < RUN; ++i) {
            const int r = r0 + i;
            const bool has_next = ((r & (SEQ - 1)) != SEQ - 1);
            if (has_next) { unpack8(*(const u32x4*)(ZP + (size_t)(r + 1) * (2 * DFF) + zc), ng); unpack8(*(const u32x4*)(ZP + (size_t)(r + 1) * (2 * DFF) + zc + 128), nv); }
            else {
#pragma unroll
                for (int e = 0; e < 8; ++e) { ng[e] = 0.f; nv[e] = 0.f; } }
            float o[8];
#pragma unroll
            for (int e = 0; e < 8; ++e) { const float zg = wg[0][e] * pg[e] + wg[1][e] * cgv[e] + wg[2][e] * ng[e] + bg[e];
                const float zv = wv[0][e] * pv[e] + wv[1][e] * cvv[e] + wv[2][e] * nv[e] + bv[e];
                o[e] = zg * sigm(zg) * zv; pg[e] = cgv[e]; pv[e] = cvv[e]; cgv[e] = ng[e]; cvv[e] = nv[e]; }
            *(u32x4*)(ACT + (size_t)r * DFF + cg_) = pack8(o);
        }
    }
}
#ifndef PREP_WAVES
#define PREP_WAVES 4
#endif
#ifndef REP_P3A
#define REP_P3A 1
#endif
#ifndef REP_WKV
#define REP_WKV 1
#endif
#ifndef REP_S5
#define REP_S5 1
#endif
#ifndef REP_P2
#define REP_P2 1
#endif
__global__ void __launch_bounds__(NWAVES * 64, 2) mega_fwd(Args a) {
    extern __shared__ __attribute__((aligned(16))) unsigned char lds_raw[];
    LAS unsigned char* lds = (LAS unsigned char*)lds_raw;
    cg::grid_group grid = cg::this_grid();
    const int G = gridDim.x, NGW = G * NWAVES;
#define CG_SYNC() do { asm volatile("s_waitcnt vmcnt(0)" ::: "memory"); grid.sync(); __builtin_amdgcn_fence(__ATOMIC_ACQUIRE, "agent"); asm volatile("s_waitcnt vmcnt(0)" ::: "memory"); } while (0)
#ifdef USE_CG_SYNC
#define GRID_SYNC() CG_SYNC()
#else
#define GRID_SYNC() xcd_barrier(xbar)
#endif
#define PHASE_IDS() int tid_ = threadIdx.x; asm volatile("" : "+v"(tid_)); const int tid = tid_, lane = tid & 63, wave = __builtin_amdgcn_readfirstlane(tid >> 6), gw = blockIdx.x * NWAVES + wave; (void)gw; (void)lane
    unsigned char* ws = a.ws;
    const float* x = a.in[0]; const float* ctx = a.in[2];
    float* mod = (float*)(ws + WS_MOD);
    bf16_t* HB = (bf16_t*)(ws + WS_HB); bf16_t* U = (bf16_t*)(ws + WS_U); bf16_t* RW = (bf16_t*)(ws + WS_RW); bf16_t* YG = (bf16_t*)(ws + WS_YG);
    bf16_t* GA = (bf16_t*)(ws + WS_GA); bf16_t* GB = (bf16_t*)(ws + WS_GB); bf16_t* RPRE = (bf16_t*)(ws + WS_RPRE); bf16_t* MERGED = (bf16_t*)(ws + WS_MERGED);
    bf16_t* ZPRE = (bf16_t*)(ws + WS_ZPRE); bf16_t* ACT = (bf16_t*)(ws + WS_ACT);

    volatile LAS unsigned* xst = (volatile LAS unsigned*)(lds + LDS_BYTES - 64);
    if (threadIdx.x < 2) xst[threadIdx.x] = 0u;
    __syncthreads();
    const XcdBarrier xbar = xcd_barrier_post((unsigned*)(ws + WS_BAR), xst);
    { PHASE_IDS(); phase_prep(a, lds, G, tid, wave, lane); }
    if (a.ws == nullptr) CG_SYNC();
    GRID_SYNC();
#ifdef EXTRA_SYNCS
    for (int es = 0; es < EXTRA_SYNCS; ++es) GRID_SYNC();
#endif
    { PHASE_IDS(); norm_mod_rows(x, ctx, TA, mod, 0, 1024, a.in[6], HB, gw, NGW, lane); }
    GRID_SYNC();
    for (int rep = 0; rep < REP_P2; ++rep) {
    { pg8::Gemm g{HB, (const bf16_t*)(ws + WS_WIN_A), TA, 4352, 1024}; pg8::StaticOrder S; S.init(TA, 4352, G, (int)blockIdx.x);
      EpiSplitUR E{U, RW}; pg8::gemm_phase(lds, g, S, E); }
    GRID_SYNC();
    }
#if !defined(S5_IN_P3A)
    { PHASE_IDS();
      LAS float* buL = (LAS float*)(lds + wave * P3_S5_BYTES); LAS bf16_t* HL = (LAS bf16_t*)(lds + wave * P3_S5_BYTES + 8448);
      if (wave < 4) for (int r2 = 0; r2 < REP_S5; ++r2) for (int item = blockIdx.x * 4 + wave; item < 1024; item += 4 * G) { s5_chain(a, buL, HL, 2 * item, lane); asm volatile("s_waitcnt vmcnt(0)" ::: "memory"); s5_chain(a, buL, HL, 2 * item + 1, lane); }
    }
    GRID_SYNC();
#endif
    for (int rep = 0; rep < REP_P3A; ++rep) {
#ifndef SKIP_P3A
    { PHASE_IDS();
        volatile LAS unsigned* flg = (volatile LAS unsigned*)(lds + P3_FLG);
        if (tid < 16) flg[tid] = 0u;
        if (tid >= 64 && tid < 128) ((LAS unsigned*)(lds + P3_ZERO))[tid - 64] = 0u;
        __syncthreads();
        const int bh = (G == 256) ? ((2 * ((int)blockIdx.x & 7) + (((int)blockIdx.x >> 3) >> 4)) * 16 + (((int)blockIdx.x >> 3) & 15)) : (int)blockIdx.x;
        if (wave < 4) {
#ifdef SCAN_PRIO
            __builtin_amdgcn_s_setprio(3);
#endif
            const int c = wave >> 1, hw = wave & 1;
            LAS float* ring = (LAS float*)(lds + P3_RING) + c * NSLOT * SLOT_F; LAS float* yb = (LAS float*)(lds + P3_YB + wave * 16 * YS * 4);
            unsigned seq0 = 0u;
            for (int chain = bh * 2 + c; chain < 512; chain += 2 * G, seq0 += 144u) wkv_scan_wave(a, ring, yb, (const LAS float*)(lds + P3_ZERO), flg + 4 * c, flg + 4 * c + 1 + hw, chain, hw, seq0, lane);
#ifdef SCAN_PRIO
            __builtin_amdgcn_s_setprio(0);
#endif
        } else if (PREP_WAVES == 2 && wave >= 6) {
#ifdef S5_IN_P3A
            const int i = wave - 6;
            LAS float* buL = (LAS float*)(lds + P3_END + i * P3_S5_BYTES); LAS bf16_t* HL = (LAS bf16_t*)(lds + P3_END + i * P3_S5_BYTES + 8448);
            for (int base = blockIdx.x * 4; base < 1024; base += 4 * G)
                for (int j = 0; j < 2; ++j) { const int item = base + 2 * i + j; s5_chain(a, buL, HL, 2 * item, lane); asm volatile("s_waitcnt vmcnt(0)" ::: "memory"); s5_chain(a, buL, HL, 2 * item + 1, lane); }
#endif
        } else if (PREP_WAVES == 4 || wave < 6) {
#ifdef PREP_PRIO
            __builtin_amdgcn_s_setprio(3);
#endif
            const int c = (PREP_WAVES == 4) ? ((wave - 4) >> 1) : (wave - 4), parity = (PREP_WAVES == 4) ? ((wave - 4) & 1) : 0;
            LAS float* ring = (LAS float*)(lds + P3_RING) + c * NSLOT * SLOT_F; LAS float* cst = (LAS float*)(lds + P3_CST + (wave - 4) * 2560);
            unsigned seq0 = 0u;
            for (int chain = bh * 2 + c; chain < 512; chain += 2 * G, seq0 += 144u) wkv_prep_wave(a, ring, cst, flg + 4 * c, flg + 4 * c + 1, flg + 4 * c + 2, chain, seq0, parity, (PREP_WAVES == 4) ? 2 : 1, lane);
        }
    }
#endif
    GRID_SYNC();
    }
    { PHASE_IDS(); wkv_readout(a, gw, NGW, lane); }
    GRID_SYNC();
    { pg8::Gemm g{YG, (const bf16_t*)(ws + WS_WGLU), T, 2048, 1024}; pg8::StaticOrder S; S.init(T, 2048, G, (int)blockIdx.x);
      EpiGlu E{GA}; pg8::gemm_phase(lds, g, S, E); }
    { pg8::Gemm g{RPRE, (const bf16_t*)(ws + WS_WROUT), T, 1024, 1024}; pg8::StaticOrder S; S.init(T, 1024, G, (int)blockIdx.x);
      EpiPlainBf16 E{GB, 1024}; pg8::gemm_phase(lds, g, S, E); }
    GRID_SYNC();
    { pg8::Gemm g{HB, (const bf16_t*)(ws + WS_WIN_G), T, 2048, 1024}; pg8::StaticOrder S; S.init(T, 2048, G, (int)blockIdx.x);
      EpiMerge E{GA, GB, MERGED}; pg8::gemm_phase(lds, g, S, E); }
    GRID_SYNC();
    { pg8::Gemm g{MERGED, (const bf16_t*)(ws + WS_WOUT), T, 1024, 1024}; pg8::StaticOrder S; S.init(T, 1024, G, (int)blockIdx.x);
      EpiRes E{x, a.out, mod + 2048}; pg8::gemm_phase(lds, g, S, E); }
    GRID_SYNC();
    { PHASE_IDS(); norm_mod_rows(a.out, nullptr, T, mod, 3072, 4096, a.in[7], HB, gw, NGW, lane); }
    GRID_SYNC();
    for (int half = 0; half < 2; ++half) {
        { pg8::Gemm g{HB + (size_t)half * (T / 2) * DM, (const bf16_t*)(ws + WS_WUP), T / 2, 2 * DFF, 1024}; pg8::StaticOrder S; S.init(T / 2, 2 * DFF, G, (int)blockIdx.x);
          EpiPlainBf16 E{ZPRE, 2 * DFF}; pg8::gemm_phase(lds, g, S, E); }
        GRID_SYNC();
        { PHASE_IDS(); conv_act(a, ZPRE, ACT + (size_t)half * (T / 2) * DFF, T / 2, gw, NGW, lane); }
        GRID_SYNC();
    }
    { pg8::Gemm g{ACT, (const bf16_t*)(ws + WS_WDOWN), T, 1024, DFF}; pg8::StaticOrder S; S.init(T, 1024, G, (int)blockIdx.x);
      EpiRes E{a.out, a.out, mod + 5120}; pg8::gemm_phase(lds, g, S, E); }
    GRID_SYNC();
    { PHASE_IDS(); final_norm_rows(a.out, a.in[35], gw, NGW, lane); }
}

extern "C" void kernel_launch(void* const* d_in, const int* in_sizes, int n_in, void* d_out, int out_size, void* d_ws, size_t ws_size, hipStream_t stream) {
    static int grid = 0;
    if (grid == 0) {
        if (n_in != 36 || out_size != T * DM || ws_size < WS_END) { fprintf(stderr, "kernel_launch: unexpected shapes: n_in %d out %d ws %zu (need %zu)\n", n_in, out_size, ws_size, (size_t)WS_END); grid = -1; return; }
        int dev = 0, cus = 0, per_cu = 0;
        if (hipGetDevice(&dev) != hipSuccess || hipDeviceGetAttribute(&cus, hipDeviceAttributeMultiprocessorCount, dev) != hipSuccess) { grid = -1; return; }
        if (hipFuncSetAttribute((const void*)mega_fwd, hipFuncAttributeMaxDynamicSharedMemorySize, LDS_BYTES) != hipSuccess) { fprintf(stderr, "kernel_launch: hipFuncSetAttribute failed\n"); grid = -1; return; }
        if (hipOccupancyMaxActiveBlocksPerMultiprocessor(&per_cu, (const void*)mega_fwd, NWAVES * 64, LDS_BYTES) != hipSuccess || per_cu < 1) per_cu = 1;
        (void)hipGetLastError();
        grid = cus * per_cu;
        fprintf(stderr, "kernel_launch: grid %d (cus %d x %d), ws %zu\n", grid, cus, per_cu, ws_size);
    }
    if (grid < 0) return;
    if (hipMemsetAsync((char*)d_ws + WS_BAR, 0, 16384, stream) != hipSuccess) { fprintf(stderr, "kernel_launch: hipMemsetAsync failed\n"); return; }
    Args a{};
    for (int i = 0; i < 36; ++i) a.in[i] = (const float*)d_in[i];
    a.out = (float*)d_out; a.ws = (unsigned char*)d_ws;
    void* args[] = {&a};
    hipError_t e = hipLaunchCooperativeKernel((const void*)mega_fwd, dim3(grid), dim3(NWAVES * 64), args, LDS_BYTES, stream);
    if (e != hipSuccess) fprintf(stderr, "kernel_launch: cooperative launch failed: %s (grid %d)\n", hipGetErrorString(e), grid);
}
```
